# Optimizing an MI355X kernel written in HIP

```python
import math
import jax, jax.numpy as jnp
from jax import lax
import numpy as np

D_MODEL = 2048
BATCH = 16
SEQ = 256
DEPTH = 2
DEC_BATCH = 2
DEC_SEQ = 4096
PAST_LEN = 512

GRID_W = 64
D_MIX = D_MODEL
HG_WIDTH = D_MIX // 4
HG_HEADS = 4
HG_DK = HG_WIDTH // HG_HEADS
HG_DV = HG_WIDTH // HG_HEADS
HG_CHUNK = 64
RG_WIDTH = D_MIX // 4
RG_HEADS = 4
RG_BLOCK = RG_WIDTH // RG_HEADS
RG_CONV = 4
RG_C = 8.0
MLA_WIDTH = D_MIX - HG_WIDTH - RG_WIDTH
MLA_HEADS = 8
MLA_V_DIM = MLA_WIDTH // MLA_HEADS
MLA_NOPE_DIM = 128
MLA_ROPE_DIM = 64
MLA_QK_DIM = MLA_NOPE_DIM + MLA_ROPE_DIM
Q_LORA = 512
KV_LORA = 512
ROPE_THETA = 10000.0
Q_BLOCK = 128
IN_COLS = 5 * HG_WIDTH + 2 * RG_WIDTH + Q_LORA + KV_LORA + MLA_ROPE_DIM
N_EXPERTS = 16
CAP_FACTOR = 2
D_FF_EXPERT = 1024
DN_ALPHA = (2.0 * DEPTH) ** 0.25
DN_BETA = (8.0 * DEPTH) ** -0.25
LN_EPS = 1e-5
RMS_EPS = 1e-6

kernel_name = "hybrid_hgrn2_rglru_mla_ec_moe_diffusion_step"


def split_points():
    sizes = [HG_WIDTH] * 5 + [RG_WIDTH] * 2 + [Q_LORA, KV_LORA, MLA_ROPE_DIM]
    return [int(s) for s in np.cumsum(sizes)[:-1]]


def layer_norm(x, g, b):
    xf = x.astype(jnp.float32)
    mu = jnp.mean(xf, -1, keepdims=True)
    var = jnp.mean(jnp.square(xf - mu), -1, keepdims=True)
    return ((xf - mu) * lax.rsqrt(var + LN_EPS) * g + b).astype(x.dtype)


def rms_norm(x, g):
    xf = x.astype(jnp.float32)
    return (xf * lax.rsqrt(jnp.mean(xf * xf, -1, keepdims=True) + RMS_EPS) * g).astype(x.dtype)


def axial_rope_tables(n):
    rows = n // GRID_W
    t = jnp.arange(n)
    row = jnp.repeat(jnp.arange(rows), GRID_W).astype(jnp.float32)
    col = (t % GRID_W).astype(jnp.float32)
    half = MLA_ROPE_DIM // 2
    inv = ROPE_THETA ** (-jnp.arange(0, half, 2, dtype=jnp.float32) / half)
    ar, ac = row[:, None] * inv, col[:, None] * inv
    return jnp.cos(ar), jnp.sin(ar), jnp.cos(ac), jnp.sin(ac)


def rope_1d(x, cos, sin):
    x1, x2 = jnp.split(x, 2, axis=-1)
    return jnp.concatenate([x1 * cos - x2 * sin, x2 * cos + x1 * sin], -1)


def apply_axial_rope(x, tables):
    cr, sr, cc, sc = (a.reshape(a.shape[:1] + (1,) * (x.ndim - 3) + a.shape[1:]) for a in tables)
    xr, xc = jnp.split(x, 2, axis=-1)
    return jnp.concatenate([rope_1d(xr, cr, sr), rope_1d(xc, cc, sc)], -1).astype(x.dtype)


def block_attention(q, k, v):
    b, tq, h, dq = q.shape
    nb = tq // Q_BLOCK
    scale = dq ** -0.5
    qb = q.reshape(b, nb, Q_BLOCK, h, dq).transpose(1, 0, 2, 3, 4)

    def one(qblk):
        s = jnp.einsum('bqhd,bkhd->bhqk', qblk, k, preferred_element_type=jnp.float32) * scale
        p = jax.nn.softmax(s, axis=-1)
        return jnp.einsum('bhqk,bkhd->bqhd', p.astype(v.dtype), v)

    o = lax.map(one, qb)
    return o.transpose(1, 0, 2, 3, 4).reshape(b, tq, h, v.shape[-1])


def hgrn2_chunk_scan(q, k, v, log_f, s0):
    b, t, h, _ = q.shape
    n = t // HG_CHUNK

    def to_chunks(a):
        return a.reshape(b, n, HG_CHUNK, h, a.shape[-1]).transpose(1, 0, 3, 2, 4)

    causal = jnp.tril(jnp.ones((HG_CHUNK, HG_CHUNK), bool))[:, :, None]

    def step(s, inp):
        qc, kc, vc, lf = inp
        cum = jnp.cumsum(lf, axis=-2)
        inter = jnp.einsum('bhcd,bhde->bhce', qc * jnp.exp(cum), s)
        diff = cum[:, :, :, None, :] - cum[:, :, None, :, :]
        decay = jnp.exp(jnp.where(causal, diff, -jnp.inf))
        att = jnp.einsum('bhtd,bhsd,bhtsd->bhts', qc, kc, decay)
        o = inter + jnp.einsum('bhts,bhse->bhte', att, vc)
        last = cum[:, :, -1:, :]
        s_new = jnp.exp(last[:, :, 0, :])[..., None] * s + jnp.einsum('bhsd,bhse->bhde', kc * jnp.exp(last - cum), vc)
        return s_new, o

    s_fin, o = lax.scan(step, s0, (to_chunks(q), to_chunks(k), to_chunks(v), to_chunks(log_f)))
    return o.transpose(1, 0, 3, 2, 4).reshape(b, t, h, v.shape[-1]), s_fin


def hgrn2_direction(q, k, v, log_f, s0, reverse):
    if reverse:
        q, k, v, log_f = (jnp.flip(a, axis=1) for a in (q, k, v, log_f))
    o, s = hgrn2_chunk_scan(q, k, v, log_f, s0)
    if reverse:
        o = jnp.flip(o, axis=1)
    return o, s


def linear_scan(a, bx, h0):
    def comb(l, r):
        return l[0] * r[0], r[0] * l[1] + r[1]
    a_cum, b_cum = lax.associative_scan(comb, (a, bx), axis=1)
    h = a_cum * h0[:, None, :] + b_cum
    return h, h[:, -1]


def rglru_direction(xc, w_r, b_r, w_i, b_i, lam, h0, reverse):
    if reverse:
        xc = jnp.flip(xc, axis=1)
    b, t, w = xc.shape
    xb = xc.reshape(b, t, RG_HEADS, RG_BLOCK)
    r = jax.nn.sigmoid(jnp.einsum('bthi,hij->bthj', xb, w_r.astype(jnp.float32)).reshape(b, t, w) + b_r)
    ig = jax.nn.sigmoid(jnp.einsum('bthi,hij->bthj', xb, w_i.astype(jnp.float32)).reshape(b, t, w) + b_i)
    log_a = -RG_C * r * jax.nn.softplus(-lam.astype(jnp.float32))
    a = jnp.exp(log_a)
    gated = jnp.sqrt(-jnp.expm1(2.0 * log_a)) * (ig * xc)
    h, h_last = linear_scan(a, gated, h0)
    if reverse:
        h = jnp.flip(h, axis=1)
    return h, h_last


def centred_dwconv(x, w, bias):
    y = lax.conv_general_dilated(
        x, w[:, None, :], window_strides=(1,),
        padding=[(RG_CONV // 2, RG_CONV - 1 - RG_CONV // 2)],
        dimension_numbers=('NWC', 'WIO', 'NWC'), feature_group_count=x.shape[-1])
    return y + bias


def mixer(h, p, ctx=None):
    f32 = jnp.float32
    b, t, _ = h.shape
    z = jnp.einsum('btd,de->bte', h, p['w_in'])
    (q_hg, ff_hg, fb_hg, i_hg, g_hg, x_rg, y_rg, cq, ckv_raw, kpe) = jnp.split(z, split_points(), axis=-1)

    qh = jax.nn.silu(q_hg.astype(f32)).reshape(b, t, HG_HEADS, HG_DK)
    vh = i_hg.astype(f32).reshape(b, t, HG_HEADS, HG_DV)
    hg_outs, hg_states = [], []
    for d, f_raw in enumerate((ff_hg, fb_hg)):
        lb = p['hg_lb'][d]
        f = (lb + (1.0 - lb) * jax.nn.sigmoid(f_raw.astype(f32))).reshape(b, t, HG_HEADS, HG_DK)
        s0 = jnp.zeros((b, HG_HEADS, HG_DK, HG_DV), f32) if ctx is None else ctx['hg'][:, d].astype(f32)
        o, s = hgrn2_direction(qh, 1.0 - f, vh, jnp.log(f), s0, reverse=(d == 1))
        hg_outs.append(o)
        hg_states.append(s)
    o_hg = rms_norm(hg_outs[0] + hg_outs[1], p['hg_norm_g'].reshape(HG_HEADS, HG_DV))
    o_hg = o_hg * jax.nn.silu(g_hg.astype(f32)).reshape(b, t, HG_HEADS, HG_DV)
    o_hg = o_hg.reshape(b, t, HG_WIDTH).astype(h.dtype)

    xc = centred_dwconv(x_rg, p['rg_conv_w'], p['rg_conv_b']).astype(f32)
    rg_outs, rg_states = [], []
    for d in range(2):
        h0 = jnp.zeros((b, RG_WIDTH), f32) if ctx is None else ctx['rg'][:, d].astype(f32)
        hd, hl = rglru_direction(xc, p['rg_w_r'][d], p['rg_b_r'][d], p['rg_w_i'][d], p['rg_b_i'][d],
                                 p['rg_lambda'][d], h0, reverse=(d == 1))
        rg_outs.append(hd)
        rg_states.append(hl)
    o_rg = ((rg_outs[0] + rg_outs[1]) * jax.nn.gelu(y_rg.astype(f32))).astype(h.dtype)

    qm = jnp.einsum('btr,re->bte', rms_norm(cq, p['q_norm_g']), p['w_uq']).reshape(b, t, MLA_HEADS, MLA_QK_DIM)
    q_nope, q_pe = qm[..., :MLA_NOPE_DIM], qm[..., MLA_NOPE_DIM:]
    ckv = rms_norm(ckv_raw, p['kv_norm_g'])
    if ctx is None:
        ckv_all, kpe_all = ckv, kpe
    else:
        tabs = axial_rope_tables(t)
        q_pe = apply_axial_rope(q_pe, tabs)
        ckv_all = jnp.concatenate([ckv, ctx['ckv'].astype(ckv.dtype)], axis=1)
        kpe_all = jnp.concatenate([apply_axial_rope(kpe, tabs), ctx['kpe'].astype(kpe.dtype)], axis=1)
    tk = ckv_all.shape[1]
    k_nope = jnp.einsum('btr,re->bte', ckv_all, p['w_uk']).reshape(b, tk, MLA_HEADS, MLA_NOPE_DIM)
    v = jnp.einsum('btr,re->bte', ckv_all, p['w_uv']).reshape(b, tk, MLA_HEADS, MLA_V_DIM)
    k = jnp.concatenate([k_nope, jnp.broadcast_to(kpe_all[:, :, None, :], (b, tk, MLA_HEADS, MLA_ROPE_DIM))], -1)
    o_mla = block_attention(jnp.concatenate([q_nope, q_pe], -1), k, v).reshape(b, t, MLA_WIDTH)

    out = jnp.einsum('bte,ed->btd', jnp.concatenate([o_hg, o_rg, o_mla.astype(h.dtype)], -1), p['w_out'])
    if ctx is None:
        return out, (ckv, kpe, jnp.stack(hg_states, 1), jnp.stack(rg_states, 1))
    return out


def expert_choice_ffn(h, w_router, w_gate, w_up, w_down):
    b, t, d = h.shape
    n = b * t
    cap = CAP_FACTOR * n // N_EXPERTS
    xf = h.reshape(n, d)
    probs = jax.nn.softmax(jnp.einsum('nd,de->ne', xf, w_router).astype(jnp.float32), axis=-1)
    gates, idx = lax.top_k(probs.T, cap)
    xs = jnp.take(xf, idx, axis=0)
    hid = jax.nn.silu(jnp.einsum('ecd,edf->ecf', xs, w_gate)) * jnp.einsum('ecd,edf->ecf', xs, w_up)
    ys = jnp.einsum('ecf,efd->ecd', hid, w_down) * gates[..., None].astype(h.dtype)
    out = jnp.zeros_like(xf).at[idx.reshape(-1)].add(ys.reshape(-1, d))
    return out.reshape(b, t, d)


def trunk_layer(x, mod, p, ctx=None):
    sh1, sc1, g1, sh2, sc2, g2 = jnp.split(mod, 6, axis=-1)
    hm = x * (1.0 + sc1) + sh1
    if ctx is None:
        m, st = mixer(hm, p)
    else:
        m, st = mixer(hm, p, ctx), None
    x = layer_norm(DN_ALPHA * x + g1 * m, p['ln1_g'], p['ln1_b'])
    hf = x * (1.0 + sc2) + sh2
    f = expert_choice_ffn(hf, p['moe_router'], p['moe_w_gate'], p['moe_w_up'], p['moe_w_down'])
    x = layer_norm(DN_ALPHA * x + g2 * f, p['ln2_g'], p['ln2_b'])
    return x, st


def setup_inputs(seed: int = 0) -> dict:
    key = jax.random.key(seed)
    ks = jax.random.split(key, 40)
    f32 = jnp.float32

    def nrm(k, shape, scale=1.0):
        return jax.random.normal(k, shape, f32) * scale

    a8 = jax.random.uniform(ks[15], (DEPTH, 2, RG_WIDTH), f32, minval=0.9, maxval=0.999)
    a0 = a8 ** (1.0 / RG_C)
    return {
        'x_prompt': nrm(ks[0], (BATCH, SEQ, D_MODEL)),
        'x_sample': nrm(ks[1], (DEC_BATCH, DEC_SEQ, D_MODEL)),
        'cache_mla_ckv': nrm(ks[2], (DEC_BATCH, DEPTH, PAST_LEN, KV_LORA)),
        'cache_mla_kpe': nrm(ks[3], (DEC_BATCH, DEPTH, PAST_LEN, MLA_ROPE_DIM)),
        'state_hgrn': nrm(ks[4], (DEC_BATCH, DEPTH, 2, HG_HEADS, HG_DK, HG_DV), 0.5),
        'state_rglru': nrm(ks[5], (DEC_BATCH, DEPTH, 2, RG_WIDTH), 0.5),
        'c': nrm(ks[6], (DEC_BATCH, D_MODEL)),
        'c_ctx': nrm(ks[7], (D_MODEL,)),
        'w_in': nrm(ks[8], (DEPTH, D_MODEL, IN_COLS), D_MODEL ** -0.5),
        'w_out': nrm(ks[9], (DEPTH, D_MIX, D_MODEL), DN_BETA * D_MIX ** -0.5),
        'hg_lb_logits': nrm(ks[10], (DEPTH, 2, HG_WIDTH)),
        'hg_norm_g': 1.0 + nrm(ks[11], (DEPTH, HG_WIDTH), 0.02),
        'rg_conv_w': nrm(ks[12], (DEPTH, RG_CONV, RG_WIDTH), RG_CONV ** -0.5),
        'rg_conv_b': nrm(ks[13], (DEPTH, RG_WIDTH), 0.02),
        'rg_w_r': nrm(ks[14], (DEPTH, 2, RG_HEADS, RG_BLOCK, RG_BLOCK), RG_BLOCK ** -0.5),
        'rg_b_r': nrm(ks[16], (DEPTH, 2, RG_WIDTH), 0.02),
        'rg_w_i': nrm(ks[17], (DEPTH, 2, RG_HEADS, RG_BLOCK, RG_BLOCK), RG_BLOCK ** -0.5),
        'rg_b_i': nrm(ks[18], (DEPTH, 2, RG_WIDTH), 0.02),
        'rg_lambda': jnp.log(a0) - jnp.log1p(-a0),
        'mla_q_norm_g': 1.0 + nrm(ks[19], (DEPTH, Q_LORA), 0.02),
        'mla_kv_norm_g': 1.0 + nrm(ks[20], (DEPTH, KV_LORA), 0.02),
        'mla_w_uq': nrm(ks[21], (DEPTH, Q_LORA, MLA_HEADS * MLA_QK_DIM), Q_LORA ** -0.5),
        'mla_w_uk': nrm(ks[22], (DEPTH, KV_LORA, MLA_HEADS * MLA_NOPE_DIM), KV_LORA ** -0.5),
        'mla_w_uv': nrm(ks[23], (DEPTH, KV_LORA, MLA_HEADS * MLA_V_DIM), DN_BETA * KV_LORA ** -0.5),
        'ada_w': nrm(ks[24], (DEPTH, D_MODEL, 6 * D_MODEL), 0.5 * D_MODEL ** -0.5),
        'ada_b': nrm(ks[25], (DEPTH, 6 * D_MODEL), 0.02),
        'ln1_g': 1.0 + nrm(ks[26], (DEPTH, D_MODEL), 0.02),
        'ln1_b': nrm(ks[27], (DEPTH, D_MODEL), 0.02),
        'ln2_g': 1.0 + nrm(ks[28], (DEPTH, D_MODEL), 0.02),
        'ln2_b': nrm(ks[29], (DEPTH, D_MODEL), 0.02),
        'moe_router': nrm(ks[30], (DEPTH, D_MODEL, N_EXPERTS), D_MODEL ** -0.5),
        'moe_w_gate': nrm(ks[31], (DEPTH, N_EXPERTS, D_MODEL, D_FF_EXPERT), D_MODEL ** -0.5),
        'moe_w_up': nrm(ks[32], (DEPTH, N_EXPERTS, D_MODEL, D_FF_EXPERT), DN_BETA * D_MODEL ** -0.5),
        'moe_w_down': nrm(ks[33], (DEPTH, N_EXPERTS, D_FF_EXPERT, D_MODEL), DN_BETA * D_FF_EXPERT ** -0.5),
    }


def reference(x_prompt, x_sample, cache_mla_ckv, cache_mla_kpe, state_hgrn, state_rglru, c, c_ctx,
              w_in, w_out, hg_lb_logits, hg_norm_g, rg_conv_w, rg_conv_b, rg_w_r, rg_b_r, rg_w_i, rg_b_i,
              rg_lambda, mla_q_norm_g, mla_kv_norm_g, mla_w_uq, mla_w_uk, mla_w_uv, ada_w, ada_b,
              ln1_g, ln1_b, ln2_g, ln2_b, moe_router, moe_w_gate, moe_w_up, moe_w_down):
    lb_cum = jnp.cumsum(jax.nn.softmax(hg_lb_logits.astype(jnp.float32), axis=0), axis=0)
    lb_all = lb_cum - lb_cum[0:1]

    def layer_params(l):
        return {
            'w_in': w_in[l], 'w_out': w_out[l], 'hg_lb': lb_all[l], 'hg_norm_g': hg_norm_g[l],
            'rg_conv_w': rg_conv_w[l], 'rg_conv_b': rg_conv_b[l], 'rg_w_r': rg_w_r[l], 'rg_b_r': rg_b_r[l],
            'rg_w_i': rg_w_i[l], 'rg_b_i': rg_b_i[l], 'rg_lambda': rg_lambda[l],
            'q_norm_g': mla_q_norm_g[l], 'kv_norm_g': mla_kv_norm_g[l],
            'w_uq': mla_w_uq[l], 'w_uk': mla_w_uk[l], 'w_uv': mla_w_uv[l],
            'ln1_g': ln1_g[l], 'ln1_b': ln1_b[l], 'ln2_g': ln2_g[l], 'ln2_b': ln2_b[l],
            'moe_router': moe_router[l], 'moe_w_gate': moe_w_gate[l], 'moe_w_up': moe_w_up[l],
            'moe_w_down': moe_w_down[l],
        }

    y_prompt = x_prompt
    ckvs, kpes, hgs, rgs = [], [], [], []
    for l in range(DEPTH):
        p = layer_params(l)
        mod = (jnp.einsum('d,de->e', jax.nn.silu(c_ctx), ada_w[l]) + ada_b[l])[None, None, :]
        y_prompt, (ckv_l, kpe_l, hg_l, rg_l) = trunk_layer(y_prompt, mod, p)
        ckvs.append(ckv_l)
        kpes.append(kpe_l)
        hgs.append(hg_l)
        rgs.append(rg_l)
    new_mla_ckv = jnp.stack(ckvs, axis=1)
    new_mla_kpe = jnp.stack(kpes, axis=1)
    new_state_hgrn = jnp.stack(hgs, axis=1)
    new_state_rglru = jnp.stack(rgs, axis=1)

    y_sample = x_sample
    for l in range(DEPTH):
        p = layer_params(l)
        mod = (jnp.einsum('bd,de->be', jax.nn.silu(c), ada_w[l]) + ada_b[l])[:, None, :]
        ctx = {'ckv': cache_mla_ckv[:, l], 'kpe': cache_mla_kpe[:, l],
               'hg': state_hgrn[:, l], 'rg': state_rglru[:, l]}
        y_sample, _ = trunk_layer(y_sample, mod, p, ctx)

    return (y_prompt, y_sample, new_mla_ckv, new_mla_kpe, new_state_hgrn, new_state_rglru)
```

```cpp
#include <hip/hip_runtime.h>
#include <cstdio>
#include <cstdint>

constexpr int DM = 2048, NCTX = 4096, NLAT = 8192, NT = NCTX + NLAT, DEPTH = 2;
constexpr int SEQC = 256, SEQL = 4096, NSEQ = 18, PAST = 512;
constexpr int INC = 4672, LDZ = 4864;
constexpr int ZQ = 0, ZFF = 512, ZFB = 1024, ZI = 1536, ZG = 2048, ZXR = 2560, ZYR = 3072, ZCQ = 3584, ZCKV = 4096, ZKPE = 4608;
constexpr int NKV = NCTX + 2 * (SEQL + PAST);
constexpr int NEXP = 16, CAPC = 512, CAPL = 1024, EROWS = CAPC + CAPL, NSLOT = NEXP * EROWS, DFF = 1024;
constexpr float ALPHA = 1.41421356237309515f;
constexpr size_t O_Y = 0, O_CKV = (size_t)NT * DM, O_KPE = O_CKV + (size_t)16 * 2 * 256 * 512, O_HG = O_KPE + (size_t)16 * 2 * 256 * 64,
                 O_RG = O_HG + (size_t)16 * 2 * 2 * 4 * 128 * 128, O_END = O_RG + (size_t)16 * 2 * 2 * 512;

typedef unsigned short bf16_t;
__device__ __forceinline__ float bf2f(bf16_t b) { return __uint_as_float(((unsigned)b) << 16); }
__device__ __forceinline__ bf16_t f2bf(float f) { unsigned u = __float_as_uint(f); u += 0x7FFFu + ((u >> 16) & 1u); return (bf16_t)(u >> 16); }
__device__ __forceinline__ float sigmoidf_(float x) { return 1.0f / (1.0f + expf(-x)); }
__device__ __forceinline__ float siluf_(float x) { return x * sigmoidf_(x); }
__device__ __forceinline__ float gelu_tanh_(float x) { return 0.5f * x * (1.0f + tanhf(0.7978845608028654f * (x + 0.044715f * x * x * x))); }

constexpr size_t al256(size_t x) { return (x + 255) / 256 * 256; }
constexpr size_t WS_CTL = 0, CTL_BYTES = 1u << 20;
constexpr size_t WS_MODS = WS_CTL + CTL_BYTES;
constexpr size_t WS_LB = WS_MODS + al256((size_t)2 * 3 * 6 * DM * 4);
constexpr size_t WS_ROPE = WS_LB + al256((size_t)2 * 2 * 512 * 4);
constexpr size_t WS_XN = WS_ROPE + al256((size_t)2 * 64 * 16 * 4);
constexpr size_t WS_HM = WS_XN + al256((size_t)NT * DM * 4);
constexpr size_t WS_Z = WS_HM + al256((size_t)NT * DM * 2);
constexpr size_t WS_CQN = WS_Z + al256((size_t)NT * LDZ * 2);
constexpr size_t WS_CKVA = WS_CQN + al256((size_t)NT * 512 * 2);
constexpr size_t WS_KPEA = WS_CKVA + al256((size_t)NKV * 512 * 2);
constexpr size_t WS_QM = WS_KPEA + al256((size_t)NKV * 64 * 2);
constexpr size_t WS_KN = WS_QM + al256((size_t)NT * 1536 * 2);
constexpr size_t WS_VV = WS_KN + al256((size_t)NKV * 1024 * 2);
constexpr size_t WS_OMIX = WS_VV + al256((size_t)NKV * 1024 * 2);
constexpr size_t WS_XCV = WS_OMIX + al256((size_t)NT * DM * 2);
constexpr size_t WS_RGA = WS_XCV + al256((size_t)NT * 512 * 4);
constexpr size_t WS_RGX = WS_RGA + al256((size_t)2 * NT * 512 * 4);
constexpr size_t WS_RGH = WS_RGX + al256((size_t)2 * NT * 512 * 4);
constexpr size_t WS_OHG = WS_RGH + al256((size_t)2 * NT * 512 * 4);
constexpr size_t WS_X1 = WS_OHG + al256((size_t)2 * NT * 512 * 4);
constexpr size_t WS_HF = WS_X1 + al256((size_t)NT * DM * 4);
constexpr size_t WS_PROB = WS_HF + al256((size_t)NT * DM * 2);
constexpr size_t WS_SLOT = WS_PROB + al256((size_t)NT * 16 * 4);
constexpr size_t WS_RIDX = WS_SLOT + al256((size_t)NT * 16 * 4);
constexpr size_t WS_GATE = WS_RIDX + al256((size_t)NSLOT * 4);
constexpr size_t WS_XS = WS_GATE + al256((size_t)NSLOT * 4);
constexpr size_t WS_HID = WS_XS + al256((size_t)NSLOT * DM * 2);
constexpr size_t WS_END = WS_HID + al256((size_t)NSLOT * DFF * 2);

#define XB_TMO      128
#define XB_XCNT(j)  (256  + 64 * (j))
#define XB_XSUB(j)  (1280 + 64 * (j))
#define XB_XGEN(j)  (2304 + 64 * (j))
#define XB_TOP      3328
#define XB_TOPGEN   3392
#define XCD_BAR_WORDS 3456
#define XB_SPIN_CAP (1u << 24)
#define LAS __attribute__((address_space(3)))
__device__ __forceinline__ unsigned xb_ld(unsigned* p)              { return __hip_atomic_load(p, __ATOMIC_RELAXED, __HIP_MEMORY_SCOPE_AGENT); }
__device__ __forceinline__ unsigned xb_add(unsigned* p, unsigned v) { return __hip_atomic_fetch_add(p, v, __ATOMIC_RELAXED, __HIP_MEMORY_SCOPE_AGENT); }
__device__ __forceinline__ unsigned xb_xcc_id() { return (unsigned)__builtin_amdgcn_s_getreg((3 << 11) | 20) & 0xFu; }
#define XB_SPIN(cond, bar) do { unsigned _sp = 0; while (cond) { __builtin_amdgcn_s_sleep(1); \
    if ((++_sp & 255u) == 0u) { if (xb_ld(&(bar)[XB_TMO])) break; if (_sp > XB_SPIN_CAP) { atomicAdd(&(bar)[XB_TMO], 1u); break; } } } } while (0)
struct XcdBarrier { unsigned* bar; unsigned x; volatile LAS unsigned* st; };
__device__ __forceinline__ XcdBarrier xcd_barrier_post(unsigned* bar, volatile LAS unsigned* st) {
    XcdBarrier b; b.bar = bar; b.x = xb_xcc_id(); b.st = st;
    if (threadIdx.x == 0) (void)xb_add(&bar[XB_XCNT(b.x)], 1u);
    return b;
}
__device__ __forceinline__ void xcd_barrier_complete(unsigned* bar, unsigned x, unsigned& nloc, unsigned& nx) {
    const unsigned G = gridDim.x * gridDim.y * gridDim.z;
    unsigned sum, cnt, mine, sp = 0u;
    for (;;) {
        sum = 0u; cnt = 0u; mine = 0u;
#pragma unroll
        for (unsigned j = 0; j < 16; ++j) { const unsigned c = xb_ld(&bar[XB_XCNT(j)]); sum += c; cnt += (c > 0u) ? 1u : 0u; mine = (j == x) ? c : mine; }
        if (sum == G) break;
        __builtin_amdgcn_s_sleep(1);
        if ((++sp & 255u) == 0u) { if (xb_ld(&bar[XB_TMO])) break; if (sp > XB_SPIN_CAP) { atomicAdd(&bar[XB_TMO], 1u); break; } }
    }
    nloc = mine > 0u ? mine : 1u; nx = cnt > 0u ? cnt : 1u;
}
__device__ __forceinline__ void xcd_barrier(const XcdBarrier& b) {
    asm volatile("s_waitcnt vmcnt(0)" ::: "memory");
    __syncthreads();
    if (threadIdx.x == 0) {
        unsigned* bar = b.bar;
        __builtin_amdgcn_s_waitcnt(0);
        unsigned nloc = b.st[0], nx = b.st[1];
        if (nloc == 0u) { xcd_barrier_complete(bar, b.x, nloc, nx); b.st[0] = nloc; b.st[1] = nx; }
        const unsigned old = xb_add(&bar[XB_XSUB(b.x)], 1u);
        const unsigned gen = old / nloc;
        if (old + 1u == (gen + 1u) * nloc) {
            __builtin_amdgcn_fence(__ATOMIC_RELEASE, "agent");
            asm volatile("s_waitcnt vmcnt(0)" ::: "memory");
            const unsigned og = xb_add(&bar[XB_TOP], 1u);
            const unsigned tg = og / nx;
            if (og + 1u == (tg + 1u) * nx) xb_add(&bar[XB_TOPGEN], 1u);
            else XB_SPIN(xb_ld(&bar[XB_TOPGEN]) == tg, bar);
            __builtin_amdgcn_fence(__ATOMIC_ACQUIRE, "agent");
            xb_add(&bar[XB_XGEN(b.x)], 1u);
            asm volatile("s_waitcnt vmcnt(0)" ::: "memory");
        } else {
            XB_SPIN(xb_ld(&bar[XB_XGEN(b.x)]) == gen, bar);
            __builtin_amdgcn_fence(__ATOMIC_ACQUIRE, "agent");
            asm volatile("s_waitcnt vmcnt(0)" ::: "memory");
        }
    }
    __syncthreads();
}

enum { I_XP = 0, I_XS, I_CCKV, I_CKPE, I_SHG, I_SRG, I_C, I_CCTX, I_WIN, I_WOUT, I_LBL, I_HGN, I_CONVW, I_CONVB, I_WR, I_BR, I_WI, I_BI, I_LAM,
       I_QNG, I_KVNG, I_WUQ, I_WUK, I_WUV, I_ADAW, I_ADAB, I_LN1G, I_LN1B, I_LN2G, I_LN2B, I_ROUT, I_WG, I_WU, I_WD, N_IN };
struct Args { const float* in[N_IN]; float* out; unsigned char* ws; int ph_lo, ph_hi; };
constexpr int NTHR = 512;
constexpr int LDS_BYTES = 147456;
constexpr int LDS_MISC = 131072 + 320;

struct F {
    const float* const* in; float* out; unsigned char* ws; unsigned char* lds; int tid, bid, nb;
    __device__ __forceinline__ float* modp(int l, int g) const { return (float*)(ws + WS_MODS) + ((size_t)l * 3 + g) * (6 * DM); }
};
__device__ __forceinline__ F launder(F f) { asm volatile("" : "+v"(f.tid)); asm volatile("" : "+s"(f.bid), "+s"(f.nb)); return f; }
__device__ __forceinline__ int tok_group(int t) { return t < NCTX ? 0 : 1 + ((t - NCTX) >> 12); }
__device__ __forceinline__ int seq_base(int s) { return s < 16 ? s * SEQC : NCTX + (s - 16) * SEQL; }
__device__ __forceinline__ int seq_len(int s) { return s < 16 ? SEQC : SEQL; }
__device__ __forceinline__ int kv_base(int s) { return s < 16 ? s * SEQC : NCTX + (s - 16) * (SEQL + PAST); }
__device__ __forceinline__ int kv_len(int s) { return s < 16 ? SEQC : SEQL + PAST; }
__device__ __forceinline__ int kv_row_of_tok(int t) { return t < NCTX ? t : NCTX + ((t - NCTX) >> 12) * (SEQL + PAST) + ((t - NCTX) & 4095); }

__device__ __forceinline__ float block_sum(float v, float* red, int tid) {
    for (int o = 32; o >= 1; o >>= 1) v += __shfl_xor(v, o);
    __syncthreads();
    if ((tid & 63) == 0) red[tid >> 6] = v;
    __syncthreads();
    float s = 0.f;
#pragma unroll
    for (int i = 0; i < 8; ++i) s += red[i];
    return s;
}

template <bool DUAL, class FA, class FB, class FB2, class FS>
__device__ __forceinline__ void ngemm(const F& f, int M, int N, int K, FA fa, FB fb, FB2 fb2, FS fs) {
    float* As = (float*)f.lds;
    float* Bs = As + 16 * 132;
    float* Bs2 = Bs + 16 * 68;
    const int tid = f.tid, ty = tid >> 4, tx = tid & 15;
    const int tm = (M + 127) / 128, tn = (N + 63) / 64;
    for (int tile = f.bid; tile < tm * tn; tile += f.nb) {
        const int r0 = (tile / tn) * 128, c0 = (tile % tn) * 64;
        float acc[4][4], acc2[4][4];
#pragma unroll
        for (int i = 0; i < 4; ++i)
#pragma unroll
            for (int j = 0; j < 4; ++j) { acc[i][j] = 0.f; acc2[i][j] = 0.f; }
        for (int k0 = 0; k0 < K; k0 += 16) {
            __syncthreads();
#pragma unroll
            for (int i = 0; i < 4; ++i) { const int e = tid + i * 512, kk = e & 15, rr = e >> 4; const int row = r0 + rr, k = k0 + kk;
                As[kk * 132 + rr] = (row < M && k < K) ? fa(row, k) : 0.f; }
#pragma unroll
            for (int i = 0; i < 2; ++i) { const int e = tid + i * 512, cc = e & 63, kk = e >> 6; const int col = c0 + cc, k = k0 + kk;
                const bool ok = (col < N && k < K);
                Bs[kk * 68 + cc] = ok ? fb(k, col) : 0.f;
                if (DUAL) Bs2[kk * 68 + cc] = ok ? fb2(k, col) : 0.f; }
            __syncthreads();
#pragma unroll
            for (int kk = 0; kk < 16; ++kk) {
                const float4 a = *(const float4*)&As[kk * 132 + ty * 4];
                const float4 b = *(const float4*)&Bs[kk * 68 + tx * 4];
                const float av[4] = {a.x, a.y, a.z, a.w}, bv[4] = {b.x, b.y, b.z, b.w};
#pragma unroll
                for (int i = 0; i < 4; ++i)
#pragma unroll
                    for (int j = 0; j < 4; ++j) acc[i][j] += av[i] * bv[j];
                if (DUAL) { const float4 b2 = *(const float4*)&Bs2[kk * 68 + tx * 4]; const float b2v[4] = {b2.x, b2.y, b2.z, b2.w};
#pragma unroll
                    for (int i = 0; i < 4; ++i)
#pragma unroll
                        for (int j = 0; j < 4; ++j) acc2[i][j] += av[i] * b2v[j]; }
            }
        }
#pragma unroll
        for (int i = 0; i < 4; ++i)
#pragma unroll
            for (int j = 0; j < 4; ++j) { const int row = r0 + ty * 4 + i, col = c0 + tx * 4 + j; if (row < M && col < N) fs(row, col, acc[i][j], acc2[i][j]); }
    }
    __syncthreads();
}
struct NoB { __device__ float operator()(int, int) const { return 0.f; } };

__device__ __forceinline__ void ph_prologue(const F& fin) {
    const F f = launder(fin);
    float* sv = (float*)f.lds;
    for (int i = f.tid; i < 3 * DM; i += NTHR) { const int g = i / DM, d = i % DM; const float c = g == 0 ? f.in[I_CCTX][d] : f.in[I_C][(g - 1) * DM + d]; sv[i] = siluf_(c); }
    __syncthreads();
    const int ncol = 2 * 6 * DM;
    for (int idx = f.bid * NTHR + f.tid; idx < ncol; idx += f.nb * NTHR) {
        const int l = idx / (6 * DM), e = idx % (6 * DM);
        const float* W = f.in[I_ADAW] + (size_t)l * DM * 6 * DM + e;
        float a0 = 0.f, a1 = 0.f, a2 = 0.f;
#pragma unroll 8
        for (int d = 0; d < DM; ++d) { const float w = W[(size_t)d * 6 * DM]; a0 += sv[d] * w; a1 += sv[DM + d] * w; a2 += sv[2 * DM + d] * w; }
        const float b = f.in[I_ADAB][(size_t)l * 6 * DM + e];
        f.modp(l, 0)[e] = a0 + b; f.modp(l, 1)[e] = a1 + b; f.modp(l, 2)[e] = a2 + b;
    }
    float* lb = (float*)(f.ws + WS_LB);
    for (int i = f.bid * NTHR + f.tid; i < 2 * 512; i += f.nb * NTHR) {
        const float x0 = f.in[I_LBL][i], x1 = f.in[I_LBL][2 * 512 + i];
        lb[i] = 0.f; lb[2 * 512 + i] = 1.0f / (1.0f + expf(x0 - x1));
    }
    float* rc = (float*)(f.ws + WS_ROPE); float* rs = rc + 64 * 16;
    for (int i = f.bid * NTHR + f.tid; i < 64 * 16; i += f.nb * NTHR) {
        const int pos = i >> 4, j = i & 15; const float inv = powf(10000.0f, -(float)(2 * j) / 32.0f); const float a = (float)pos * inv;
        rc[i] = cosf(a); rs[i] = sinf(a);
    }
    __syncthreads();
}

__device__ __forceinline__ const float* xrow(const F& f, int l, int t) {
    if (l == 0) return t < NCTX ? f.in[I_XP] + (size_t)t * DM : f.in[I_XS] + (size_t)(t - NCTX) * DM;
    return (const float*)(f.ws + WS_XN) + (size_t)t * DM;
}
__device__ __forceinline__ void ph_mod(const F& fin, int l) {
    const F f = launder(fin);
    bf16_t* hm = (bf16_t*)(f.ws + WS_HM);
    for (int t = f.bid; t < NT; t += f.nb) {
        const float* x = xrow(f, l, t); const float* m = f.modp(l, tok_group(t));
        for (int c = f.tid; c < DM; c += NTHR) hm[(size_t)t * DM + c] = f2bf(x[c] * (1.0f + m[DM + c]) + m[c]);
    }
}
__device__ __forceinline__ void ph_inproj_naive(const F& fin, int l) {
    const F f = launder(fin);
    const bf16_t* hm = (const bf16_t*)(f.ws + WS_HM); bf16_t* z = (bf16_t*)(f.ws + WS_Z); const float* W = f.in[I_WIN] + (size_t)l * DM * INC;
    ngemm<false>(f, NT, INC, DM, [=](int r, int k) { return bf2f(hm[(size_t)r * DM + k]); }, [=](int k, int c) { return W[(size_t)k * INC + c]; }, NoB(),
                 [=](int r, int c, float a, float) { z[(size_t)r * LDZ + c] = f2bf(a); });
}
__device__ __forceinline__ void ph_prep(const F& fin, int l) {
    const F f = launder(fin);
    const bf16_t* z = (const bf16_t*)(f.ws + WS_Z);
    bf16_t* cqn = (bf16_t*)(f.ws + WS_CQN); bf16_t* ckva = (bf16_t*)(f.ws + WS_CKVA); bf16_t* kpea = (bf16_t*)(f.ws + WS_KPEA); float* xcv = (float*)(f.ws + WS_XCV);
    const float* rc = (const float*)(f.ws + WS_ROPE); const float* rs = rc + 64 * 16;
    float* red = (float*)f.lds;
    const int tid = f.tid;
    for (int t = f.bid; t < NT; t += f.nb) {
        const bf16_t* zr = z + (size_t)t * LDZ;
        const bool ctx = t < NCTX; const int s = ctx ? (t >> 8) : 16 + ((t - NCTX) >> 12); const int tt = t - seq_base(s), T = seq_len(s);
        const int kr = kv_row_of_tok(t);
        {
            const float v = bf2f(zr[ZCQ + tid]); const float ss = block_sum(v * v, red, tid);
            cqn[(size_t)t * 512 + tid] = f2bf(v * rsqrtf(ss * (1.0f / 512.0f) + 1e-6f) * f.in[I_QNG][l * 512 + tid]);
        }
        {
            const float v = bf2f(zr[ZCKV + tid]); const float ss = block_sum(v * v, red, tid);
            const float o = v * rsqrtf(ss * (1.0f / 512.0f) + 1e-6f) * f.in[I_KVNG][l * 512 + tid];
            ckva[(size_t)kr * 512 + tid] = f2bf(o);
            if (ctx) f.out[O_CKV + ((size_t)((t >> 8) * 2 + l) * 256 + tt) * 512 + tid] = o;
        }
        if (tid < 64) {
            const float v = bf2f(zr[ZKPE + tid]);
            if (ctx) { kpea[(size_t)kr * 64 + tid] = f2bf(v); f.out[O_KPE + ((size_t)((t >> 8) * 2 + l) * 256 + tt) * 64 + tid] = v; }
            else {
                const int part = tid >> 5, w = tid & 31, j = w & 15; const int pos = part ? (tt & 63) : (tt >> 6);
                const float x1 = bf2f(zr[ZKPE + part * 32 + j]), x2 = bf2f(zr[ZKPE + part * 32 + 16 + j]);
                const float c = rc[pos * 16 + j], sn = rs[pos * 16 + j];
                kpea[(size_t)kr * 64 + tid] = f2bf(w < 16 ? x1 * c - x2 * sn : x2 * c + x1 * sn);
            }
        }
        {
            float a = f.in[I_CONVB][l * 512 + tid];
#pragma unroll
            for (int k = 0; k < 4; ++k) { const int u = tt + k - 2; if (u >= 0 && u < T) a += f.in[I_CONVW][(l * 4 + k) * 512 + tid] * bf2f(z[(size_t)(t + k - 2) * LDZ + ZXR + tid]); }
            xcv[(size_t)t * 512 + tid] = a;
        }
    }
    for (int i = f.bid * NTHR + tid; i < 2 * PAST * 512; i += f.nb * NTHR) {
        const int b = i / (PAST * 512), r = i % (PAST * 512), j = r / 512, c = r % 512;
        ckva[(size_t)(NCTX + b * (SEQL + PAST) + SEQL + j) * 512 + c] = f2bf(f.in[I_CCKV][(((size_t)b * 2 + l) * PAST + j) * 512 + c]);
    }
    for (int i = f.bid * NTHR + tid; i < 2 * PAST * 64; i += f.nb * NTHR) {
        const int b = i / (PAST * 64), r = i % (PAST * 64), j = r / 64, c = r % 64;
        kpea[(size_t)(NCTX + b * (SEQL + PAST) + SEQL + j) * 64 + c] = f2bf(f.in[I_CKPE][(((size_t)b * 2 + l) * PAST + j) * 64 + c]);
    }
}
__device__ __forceinline__ void ph_up_naive(const F& fin, int l) {
    const F f = launder(fin);
    const bf16_t* cqn = (const bf16_t*)(f.ws + WS_CQN); const bf16_t* ckva = (const bf16_t*)(f.ws + WS_CKVA);
    bf16_t* qm = (bf16_t*)(f.ws + WS_QM); bf16_t* kn = (bf16_t*)(f.ws + WS_KN); bf16_t* vv = (bf16_t*)(f.ws + WS_VV);
    const float* Wq = f.in[I_WUQ] + (size_t)l * 512 * 1536; const float* Wk = f.in[I_WUK] + (size_t)l * 512 * 1024; const float* Wv = f.in[I_WUV] + (size_t)l * 512 * 1024;
    ngemm<false>(f, NT, 1536, 512, [=](int r, int k) { return bf2f(cqn[(size_t)r * 512 + k]); }, [=](int k, int c) { return Wq[(size_t)k * 1536 + c]; }, NoB(),
                 [=](int r, int c, float a, float) { qm[(size_t)r * 1536 + c] = f2bf(a); });
    ngemm<true>(f, NKV, 1024, 512, [=](int r, int k) { return bf2f(ckva[(size_t)r * 512 + k]); }, [=](int k, int c) { return Wk[(size_t)k * 1024 + c]; },
                [=](int k, int c) { return Wv[(size_t)k * 1024 + c]; },
                [=](int r, int c, float a, float a2) { kn[(size_t)r * 1024 + c] = f2bf(a); vv[(size_t)r * 1024 + c] = f2bf(a2); });
}
__device__ __forceinline__ void ph_rggate_naive(const F& fin, int l) {
    const F f = launder(fin);
    const float* xcv = (const float*)(f.ws + WS_XCV); float* rga = (float*)(f.ws + WS_RGA); float* rgx = (float*)(f.ws + WS_RGX);
    for (int d = 0; d < 2; ++d)
        for (int h = 0; h < 4; ++h) {
            const float* Wr = f.in[I_WR] + ((size_t)(l * 2 + d) * 4 + h) * 128 * 128; const float* Wi = f.in[I_WI] + ((size_t)(l * 2 + d) * 4 + h) * 128 * 128;
            const float* br = f.in[I_BR] + (l * 2 + d) * 512 + h * 128; const float* bi = f.in[I_BI] + (l * 2 + d) * 512 + h * 128; const float* lam = f.in[I_LAM] + (l * 2 + d) * 512 + h * 128;
            float* oa = rga + (size_t)d * NT * 512 + h * 128; float* ox = rgx + (size_t)d * NT * 512 + h * 128; const float* xh = xcv + h * 128;
            ngemm<true>(f, NT, 128, 128, [=](int r, int k) { return xh[(size_t)r * 512 + k]; }, [=](int k, int c) { return Wr[k * 128 + c]; }, [=](int k, int c) { return Wi[k * 128 + c]; },
                        [=](int r, int c, float a, float a2) {
                            const float rr = sigmoidf_(a + br[c]), ig = sigmoidf_(a2 + bi[c]);
                            const float la = -8.0f * rr * log1pf(expf(-lam[c]));
                            oa[(size_t)r * 512 + c] = expf(la); ox[(size_t)r * 512 + c] = sqrtf(-expm1f(2.0f * la)) * (ig * xh[(size_t)r * 512 + c]); });
        }
}
__device__ void attn_unit_naive(const F& f, int s, int h, int qb) {
    const bf16_t* qm = (const bf16_t*)(f.ws + WS_QM); const bf16_t* kn = (const bf16_t*)(f.ws + WS_KN); const bf16_t* vv = (const bf16_t*)(f.ws + WS_VV);
    const bf16_t* kpea = (const bf16_t*)(f.ws + WS_KPEA); bf16_t* omix = (bf16_t*)(f.ws + WS_OMIX);
    const float* rc = (const float*)(f.ws + WS_ROPE); const float* rs = rc + 64 * 16;
    float* Ks = (float*)f.lds;
    float* Vs = Ks + 32 * 192;
    unsigned* Qs = (unsigned*)(Vs + 32 * 128);
    const int tid = f.tid, qr = tid >> 2, part4 = tid & 3;
    const int tt = qb * 128 + qr, t = seq_base(s) + tt;
    const bool lat = s >= 16;
    __syncthreads();
    for (int i = tid; i < 128 * 96; i += NTHR) {
        const int r = i / 96, w = i % 96; const int rtt = qb * 128 + r; const bf16_t* q = qm + (size_t)(seq_base(s) + rtt) * 1536 + h * 192;
        unsigned val;
        if (!lat || w < 64) val = *(const unsigned*)(q + 2 * w);
        else {
            const int part = (w - 64) >> 4, ww = (w - 64) & 15, jj = ww & 7; const bool second = ww >= 8; const int pos = part ? (rtt & 63) : (rtt >> 6);
            const float x1a = bf2f(q[128 + part * 32 + 2 * jj]), x1b = bf2f(q[128 + part * 32 + 2 * jj + 1]);
            const float x2a = bf2f(q[128 + part * 32 + 16 + 2 * jj]), x2b = bf2f(q[128 + part * 32 + 16 + 2 * jj + 1]);
            const float ca = rc[pos * 16 + 2 * jj], sa = rs[pos * 16 + 2 * jj], cb = rc[pos * 16 + 2 * jj + 1], sb = rs[pos * 16 + 2 * jj + 1];
            val = second ? ((unsigned)f2bf(x2a * ca + x1a * sa) | ((unsigned)f2bf(x2b * cb + x1b * sb) << 16))
                         : ((unsigned)f2bf(x1a * ca - x2a * sa) | ((unsigned)f2bf(x1b * cb - x2b * sb) << 16));
        }
        Qs[r * 97 + w] = val;
    }
    float o[32];
#pragma unroll
    for (int i = 0; i < 32; ++i) o[i] = 0.f;
    float m = -1e30f, lsum = 0.f;
    const float scale = 0.07216878364870322f;
    const int kb = kv_base(s), kl = kv_len(s);
    const unsigned* qrow = Qs + qr * 97;
    for (int k0 = 0; k0 < kl; k0 += 32) {
        __syncthreads();
        for (int i = tid; i < 32 * 192; i += NTHR) { const int kk = i / 192, d = i % 192; const size_t row = (size_t)(kb + k0 + kk);
            Ks[i] = d < 128 ? bf2f(kn[row * 1024 + h * 128 + d]) : bf2f(kpea[row * 64 + d - 128]); }
        for (int i = tid; i < 32 * 128; i += NTHR) { const int kk = i >> 7, e = i & 127; Vs[i] = bf2f(vv[(size_t)(kb + k0 + kk) * 1024 + h * 128 + e]); }
        __syncthreads();
        for (int kk = 0; kk < 32; ++kk) {
            const float* kr = Ks + kk * 192;
            float sc = 0.f;
#pragma unroll 8
            for (int i = 0; i < 96; ++i) { const unsigned qv = qrow[i]; sc += __uint_as_float(qv << 16) * kr[2 * i] + __uint_as_float(qv & 0xffff0000u) * kr[2 * i + 1]; }
            sc *= scale;
            const float mn = fmaxf(m, sc); const float al = expf(m - mn), p = expf(sc - mn);
            lsum = lsum * al + p; m = mn;
            const float* vr = Vs + kk * 128 + part4 * 32;
#pragma unroll
            for (int i = 0; i < 32; ++i) o[i] = o[i] * al + p * vr[i];
        }
    }
    const float inv = 1.0f / lsum;
    bf16_t* op = omix + (size_t)t * DM + 1024 + h * 128 + part4 * 32;
#pragma unroll
    for (int i = 0; i < 32; ++i) op[i] = f2bf(o[i] * inv);
}
__device__ void hgrn_unit_naive(const F& f, int l, int s, int dir) {
    const bf16_t* z = (const bf16_t*)(f.ws + WS_Z); const float* lb = (const float*)(f.ws + WS_LB) + (l * 2 + dir) * 512;
    float* ohg = (float*)(f.ws + WS_OHG) + (size_t)dir * NT * 512;
    float* sq = (float*)f.lds;
    float* sf = sq + 8 * 512; float* sk = sf + 8 * 512;
    const int tid = f.tid, h = tid >> 7, e = tid & 127;
    const int T = seq_len(s), tb = seq_base(s);
    float S[128];
    if (s >= 16) { const float* s0 = f.in[I_SHG] + ((((size_t)(s - 16) * 2 + l) * 2 + dir) * 4 + h) * 128 * 128 + e;
#pragma unroll
        for (int d = 0; d < 128; ++d) S[d] = s0[(size_t)d * 128]; }
    else {
#pragma unroll
        for (int d = 0; d < 128; ++d) S[d] = 0.f; }
    const int zf = dir ? ZFB : ZFF;
    for (int p0 = 0; p0 < T; p0 += 8) {
        __syncthreads();
        for (int i = tid; i < 8 * 512; i += NTHR) { const int j = i >> 9, c = i & 511; const int pp = p0 + j; const int tok = tb + (dir ? T - 1 - pp : pp);
            const bf16_t* zr = z + (size_t)tok * LDZ;
            const float fv = lb[c] + (1.0f - lb[c]) * sigmoidf_(bf2f(zr[zf + c]));
            sq[i] = siluf_(bf2f(zr[ZQ + c])); sf[i] = fv; sk[i] = 1.0f - fv; }
        __syncthreads();
        for (int j = 0; j < 8; ++j) {
            const int pp = p0 + j; const int tok = tb + (dir ? T - 1 - pp : pp);
            const float v = bf2f(z[(size_t)tok * LDZ + ZI + tid]);
            const float* fq = sq + j * 512 + h * 128; const float* ff = sf + j * 512 + h * 128; const float* fk = sk + j * 512 + h * 128;
            float o = 0.f;
#pragma unroll
            for (int d = 0; d < 128; d += 4) {
                const float4 q4 = *(const float4*)(fq + d), f4 = *(const float4*)(ff + d), k4 = *(const float4*)(fk + d);
                S[d] = f4.x * S[d] + k4.x * v; o += q4.x * S[d];
                S[d + 1] = f4.y * S[d + 1] + k4.y * v; o += q4.y * S[d + 1];
                S[d + 2] = f4.z * S[d + 2] + k4.z * v; o += q4.z * S[d + 2];
                S[d + 3] = f4.w * S[d + 3] + k4.w * v; o += q4.w * S[d + 3];
            }
            ohg[(size_t)tok * 512 + tid] = o;
        }
    }
    if (s < 16) { float* so = f.out + O_HG + ((((size_t)s * 2 + l) * 2 + dir) * 4 + h) * 128 * 128 + e;
#pragma unroll
        for (int d = 0; d < 128; ++d) so[(size_t)d * 128] = S[d]; }
    __syncthreads();
}
__device__ void rg_unit_naive(const F& f, int l, int s, int dir) {
    const float* rga = (const float*)(f.ws + WS_RGA) + (size_t)dir * NT * 512; const float* rgx = (const float*)(f.ws + WS_RGX) + (size_t)dir * NT * 512;
    float* rgh = (float*)(f.ws + WS_RGH) + (size_t)dir * NT * 512;
    const int c = f.tid, T = seq_len(s), tb = seq_base(s);
    float h = s >= 16 ? f.in[I_SRG][(((size_t)(s - 16) * 2 + l) * 2 + dir) * 512 + c] : 0.f;
#pragma unroll 8
    for (int pp = 0; pp < T; ++pp) { const int tok = tb + (dir ? T - 1 - pp : pp); h = rga[(size_t)tok * 512 + c] * h + rgx[(size_t)tok * 512 + c]; rgh[(size_t)tok * 512 + c] = h; }
    if (s < 16) f.out[O_RG + (((size_t)s * 2 + l) * 2 + dir) * 512 + c] = h;
}
__device__ __forceinline__ void ph_scan_naive(const F& fin, int l) {
    const F f = launder(fin);
    const int nh = NSEQ * 2;
    for (int u = f.bid; u < 2 * nh; u += f.nb) {
        const int kind = u / nh, v = u % nh; const int s = 17 - (v >> 1), dir = v & 1;
#ifndef NO_HGRN
        if (kind == 0) hgrn_unit_naive(f, l, s, dir); else
#endif
        rg_unit_naive(f, l, s, dir);
    }
    const int nu = 2 * 8 * 32 + 16 * 8 * 2;
    for (int u = (f.bid + f.nb - (2 * nh) % f.nb) % f.nb; u < nu; u += f.nb) {
#ifndef NO_ATT
        if (u < 512) { const int b = u >> 8, h = (u >> 5) & 7, qb = u & 31; attn_unit_naive(f, 16 + b, h, qb); }
        else { const int v = u - 512; attn_unit_naive(f, v >> 4, (v >> 1) & 7, v & 1); }
#endif
    }
}
__device__ __forceinline__ void ph_mixfin(const F& fin, int l) {
    const F f = launder(fin);
    const bf16_t* z = (const bf16_t*)(f.ws + WS_Z); bf16_t* omix = (bf16_t*)(f.ws + WS_OMIX);
    const float* ohg = (const float*)(f.ws + WS_OHG); const float* rgh = (const float*)(f.ws + WS_RGH);
    float* red = (float*)f.lds; const int tid = f.tid;
    for (int t = f.bid; t < NT; t += f.nb) {
        const float o = ohg[(size_t)t * 512 + tid] + ohg[(size_t)NT * 512 + (size_t)t * 512 + tid];
        float v = o * o;
        for (int m = 32; m >= 1; m >>= 1) v += __shfl_xor(v, m);
        __syncthreads();
        if ((tid & 63) == 0) red[tid >> 6] = v;
        __syncthreads();
        const float ss = red[(tid >> 7) * 2] + red[(tid >> 7) * 2 + 1];
        const float og = o * rsqrtf(ss * (1.0f / 128.0f) + 1e-6f) * f.in[I_HGN][l * 512 + tid] * siluf_(bf2f(z[(size_t)t * LDZ + ZG + tid]));
        omix[(size_t)t * DM + tid] = f2bf(og);
        const float hr = rgh[(size_t)t * 512 + tid] + rgh[(size_t)NT * 512 + (size_t)t * 512 + tid];
        omix[(size_t)t * DM + 512 + tid] = f2bf(hr * gelu_tanh_(bf2f(z[(size_t)t * LDZ + ZYR + tid])));
    }
}
__device__ __forceinline__ void ph_outproj_naive(const F& fin, int l) {
    const F f = launder(fin);
    const bf16_t* omix = (const bf16_t*)(f.ws + WS_OMIX); float* pre = (float*)(f.ws + WS_X1); const float* W = f.in[I_WOUT] + (size_t)l * DM * DM;
    const float* mods = (const float*)(f.ws + WS_MODS) + (size_t)l * 3 * 6 * DM;
    const F ff = f;
    ngemm<false>(f, NT, DM, DM, [=](int r, int k) { return bf2f(omix[(size_t)r * DM + k]); }, [=](int k, int c) { return W[(size_t)k * DM + c]; }, NoB(),
                 [=](int r, int c, float a, float) { const float* m = mods + (size_t)tok_group(r) * 6 * DM; pre[(size_t)r * DM + c] = ALPHA * xrow(ff, l, r)[c] + m[2 * DM + c] * a; });
}
__device__ __forceinline__ void ph_ln1(const F& fin, int l) {
    const F f = launder(fin);
    float* x1 = (float*)(f.ws + WS_X1); bf16_t* hf = (bf16_t*)(f.ws + WS_HF); float* probs = (float*)(f.ws + WS_PROB);
    const float* g = f.in[I_LN1G] + l * DM; const float* b = f.in[I_LN1B] + l * DM; const float* R = f.in[I_ROUT] + (size_t)l * DM * 16;
    float* red = (float*)f.lds; float* lg = red + 16; const int tid = f.tid;
    for (int t = f.bid; t < NT; t += f.nb) {
        float* xr = x1 + (size_t)t * DM; const float* m = f.modp(l, tok_group(t));
        float v[4];
#pragma unroll
        for (int i = 0; i < 4; ++i) v[i] = xr[tid + i * 512];
        const float mu = block_sum(v[0] + v[1] + v[2] + v[3], red, tid) * (1.0f / DM);
        float q = 0.f;
#pragma unroll
        for (int i = 0; i < 4; ++i) { v[i] -= mu; q += v[i] * v[i]; }
        const float rstd = rsqrtf(block_sum(q, red, tid) * (1.0f / DM) + 1e-5f);
        float lgp[16];
#pragma unroll
        for (int e = 0; e < 16; ++e) lgp[e] = 0.f;
#pragma unroll
        for (int i = 0; i < 4; ++i) { const int c = tid + i * 512; const float y = v[i] * rstd * g[c] + b[c]; xr[c] = y;
            const float hv = y * (1.0f + m[4 * DM + c]) + m[3 * DM + c]; hf[(size_t)t * DM + c] = f2bf(hv);
            const float4* rr = (const float4*)(R + (size_t)c * 16);
#pragma unroll
            for (int e4 = 0; e4 < 4; ++e4) { const float4 w = rr[e4]; lgp[e4 * 4] += hv * w.x; lgp[e4 * 4 + 1] += hv * w.y; lgp[e4 * 4 + 2] += hv * w.z; lgp[e4 * 4 + 3] += hv * w.w; } }
#pragma unroll
        for (int e = 0; e < 16; ++e) { float s = lgp[e]; for (int o = 32; o >= 1; o >>= 1) s += __shfl_xor(s, o); lgp[e] = s; }
        __syncthreads();
        if ((tid & 63) == 0) {
#pragma unroll
            for (int e = 0; e < 16; ++e) lg[(tid >> 6) * 16 + e] = lgp[e]; }
        __syncthreads();
        if (tid < 16) { float s = 0.f; for (int w = 0; w < 8; ++w) s += lg[w * 16 + tid];
            float mx = s; for (int o = 8; o >= 1; o >>= 1) mx = fmaxf(mx, __shfl_xor(mx, o));
            const float ex = expf(s - mx); float sm = ex; for (int o = 8; o >= 1; o >>= 1) sm += __shfl_xor(sm, o);
            probs[(size_t)t * 16 + tid] = ex / sm; }
    }
}
__device__ __forceinline__ void ph_select(const F& fin) {
    const F f = launder(fin);
    const float* probs = (const float*)(f.ws + WS_PROB); int* slot = (int*)(f.ws + WS_SLOT); int* ridx = (int*)(f.ws + WS_RIDX); float* gate = (float*)(f.ws + WS_GATE);
    for (int idx = f.bid * NTHR + f.tid; idx < NEXP * NT; idx += f.nb * NTHR) {
        const int e = idx / NT, t = idx % NT; const bool ctx = t < NCTX; const int j0 = ctx ? 0 : NCTX, j1 = ctx ? NCTX : NT, cap = ctx ? CAPC : CAPL;
        const float p = probs[(size_t)t * 16 + e]; int rank = 0;
        for (int j = j0; j < j1; ++j) { const float pj = probs[(size_t)j * 16 + e]; rank += (pj > p || (pj == p && j < t)) ? 1 : 0; }
        if (rank < cap) { const int row = e * EROWS + (ctx ? 0 : CAPC) + rank; ridx[row] = t; gate[row] = p; slot[(size_t)t * 16 + e] = row; }
        else slot[(size_t)t * 16 + e] = -1;
    }
}
__device__ __forceinline__ void ph_gather(const F& fin) {
    const F f = launder(fin);
    const int* ridx = (const int*)(f.ws + WS_RIDX); const uint4* hf = (const uint4*)(f.ws + WS_HF); uint4* xs = (uint4*)(f.ws + WS_XS);
    const int wave = f.tid >> 6, lane = f.tid & 63;
    for (int row = f.bid * 8 + wave; row < NSLOT; row += f.nb * 8) { const int t = ridx[row];
#pragma unroll
        for (int i = 0; i < 4; ++i) xs[(size_t)row * 256 + lane + i * 64] = hf[(size_t)t * 256 + lane + i * 64]; }
}
__device__ __forceinline__ void ph_moe1_naive(const F& fin, int l) {
    const F f = launder(fin);
    const bf16_t* xs = (const bf16_t*)(f.ws + WS_XS); bf16_t* hid = (bf16_t*)(f.ws + WS_HID);
    for (int e = 0; e < NEXP; ++e) {
        const float* Wg = f.in[I_WG] + ((size_t)l * NEXP + e) * DM * DFF; const float* Wu = f.in[I_WU] + ((size_t)l * NEXP + e) * DM * DFF;
        const bf16_t* a = xs + (size_t)e * EROWS * DM; bf16_t* o = hid + (size_t)e * EROWS * DFF;
        ngemm<true>(f, EROWS, DFF, DM, [=](int r, int k) { return bf2f(a[(size_t)r * DM + k]); }, [=](int k, int c) { return Wg[(size_t)k * DFF + c]; }, [=](int k, int c) { return Wu[(size_t)k * DFF + c]; },
                    [=](int r, int c, float g, float u) { o[(size_t)r * DFF + c] = f2bf(siluf_(g) * u); });
    }
}
__device__ __forceinline__ void ph_moe2_naive(const F& fin, int l) {
    const F f = launder(fin);
    const bf16_t* hid = (const bf16_t*)(f.ws + WS_HID); bf16_t* ys = (bf16_t*)(f.ws + WS_XS); const float* gate = (const float*)(f.ws + WS_GATE);
    for (int e = 0; e < NEXP; ++e) {
        const float* Wd = f.in[I_WD] + ((size_t)l * NEXP + e) * DFF * DM; const bf16_t* a = hid + (size_t)e * EROWS * DFF; bf16_t* o = ys + (size_t)e * EROWS * DM; const float* gt = gate + e * EROWS;
        ngemm<false>(f, EROWS, DM, DFF, [=](int r, int k) { return bf2f(a[(size_t)r * DFF + k]); }, [=](int k, int c) { return Wd[(size_t)k * DM + c]; }, NoB(),
                     [=](int r, int c, float v, float) { o[(size_t)r * DM + c] = f2bf(v * gt[r]); });
    }
}
__device__ __forceinline__ void ph_ln2(const F& fin, int l) {
    const F f = launder(fin);
    const float* x1 = (const float*)(f.ws + WS_X1); const bf16_t* ys = (const bf16_t*)(f.ws + WS_XS); const int* slot = (const int*)(f.ws + WS_SLOT);
    float* xo = l == DEPTH - 1 ? f.out + O_Y : (float*)(f.ws + WS_XN);
    const float* g = f.in[I_LN2G] + l * DM; const float* b = f.in[I_LN2B] + l * DM;
    float* red = (float*)f.lds; const int tid = f.tid;
    for (int t = f.bid; t < NT; t += f.nb) {
        const float* m = f.modp(l, tok_group(t));
        float acc[4] = {0.f, 0.f, 0.f, 0.f};
        for (int e = 0; e < NEXP; ++e) { const int r = slot[(size_t)t * 16 + e]; if (r >= 0) {
#pragma unroll
                for (int i = 0; i < 4; ++i) acc[i] += bf2f(ys[(size_t)r * DM + tid + i * 512]); } }
        float v[4];
#pragma unroll
        for (int i = 0; i < 4; ++i) { const int c = tid + i * 512; v[i] = ALPHA * x1[(size_t)t * DM + c] + m[5 * DM + c] * acc[i]; }
        const float mu = block_sum(v[0] + v[1] + v[2] + v[3], red, tid) * (1.0f / DM);
        float q = 0.f;
#pragma unroll
        for (int i = 0; i < 4; ++i) { v[i] -= mu; q += v[i] * v[i]; }
        const float rstd = rsqrtf(block_sum(q, red, tid) * (1.0f / DM) + 1e-5f);
#pragma unroll
        for (int i = 0; i < 4; ++i) { const int c = tid + i * 512; xo[(size_t)t * DM + c] = v[i] * rstd * g[c] + b[c]; }
    }
}

constexpr int PH_PER_LAYER = 13, NPH = 1 + DEPTH * PH_PER_LAYER;
__global__ void __launch_bounds__(NTHR, 2) mk_fwd(Args a) {
    extern __shared__ __attribute__((aligned(16))) unsigned char lds[];
    F f; f.in = a.in; f.out = a.out; f.ws = a.ws; f.lds = lds; f.tid = threadIdx.x; f.bid = blockIdx.x; f.nb = gridDim.x;
    volatile LAS unsigned* misc = (volatile LAS unsigned*)((LAS unsigned char*)lds + LDS_MISC);
    if (f.tid < 32) misc[f.tid] = 0u;
    __syncthreads();
    XcdBarrier bar = xcd_barrier_post((unsigned*)(a.ws + WS_CTL) + 4096, misc + 8);
    const int lo = a.ph_lo, hi = a.ph_hi;
#ifdef ONLYPH
#define PHASE(k, call) do { if (((k) == 0 ? 0 : ((k) - 1) % PH_PER_LAYER + 1) == ONLYPH) { if (lo <= (k) && (k) < hi) { call; if ((k) + 1 < hi) xcd_barrier(bar); } } } while (0)
#else
#define PHASE(k, call) do { if (lo <= (k) && (k) < hi) { call; if ((k) + 1 < hi) xcd_barrier(bar); } } while (0)
#endif
    PHASE(0, ph_prologue(f));
    for (int l = 0; l < DEPTH; ++l) {
        const int p = 1 + l * PH_PER_LAYER;
        PHASE(p + 0, ph_mod(f, l));
        PHASE(p + 1, ph_inproj_naive(f, l));
        PHASE(p + 2, ph_prep(f, l));
        PHASE(p + 3, { ph_up_naive(f, l); ph_rggate_naive(f, l); });
        PHASE(p + 4, ph_scan_naive(f, l));
        PHASE(p + 5, ph_mixfin(f, l));
        PHASE(p + 6, ph_outproj_naive(f, l));
        PHASE(p + 7, ph_ln1(f, l));
        PHASE(p + 8, ph_select(f));
        PHASE(p + 9, ph_gather(f));
        PHASE(p + 10, ph_moe1_naive(f, l));
        PHASE(p + 11, ph_moe2_naive(f, l));
        PHASE(p + 12, ph_ln2(f, l));
    }
#undef PHASE
}

extern "C" void kernel_launch(void* const* d_in, const int* in_sizes, int n_in, void* d_out, int out_size, void* d_ws, size_t ws_size, hipStream_t stream) {
    static int grid = 0;
    if (grid == 0) {
        if (n_in != N_IN || (size_t)out_size != O_END || ws_size < WS_END) { fprintf(stderr, "kernel_launch: shape mismatch n_in %d out %d ws %zu (need %zu)\n", n_in, out_size, ws_size, (size_t)WS_END); grid = -1; return; }
        int dev = 0, cus = 0, per_cu = 0;
        if (hipGetDevice(&dev) != hipSuccess || hipDeviceGetAttribute(&cus, hipDeviceAttributeMultiprocessorCount, dev) != hipSuccess) { grid = -1; return; }
        if (hipFuncSetAttribute((const void*)mk_fwd, hipFuncAttributeMaxDynamicSharedMemorySize, LDS_BYTES) != hipSuccess) { fprintf(stderr, "kernel_launch: hipFuncSetAttribute failed\n"); grid = -1; return; }
        if (hipOccupancyMaxActiveBlocksPerMultiprocessor(&per_cu, (const void*)mk_fwd, NTHR, LDS_BYTES) != hipSuccess || per_cu < 1) { fprintf(stderr, "kernel_launch: occupancy query says %d\n", per_cu); }
        (void)hipGetLastError();
        grid = cus;
    }
    if (grid < 0) return;
    if (hipMemsetAsync((char*)d_ws + WS_CTL, 0, CTL_BYTES, stream) != hipSuccess) return;
    Args a{};
    for (int i = 0; i < N_IN; ++i) a.in[i] = (const float*)d_in[i];
    a.out = (float*)d_out; a.ws = (unsigned char*)d_ws; a.ph_lo = 0; a.ph_hi = NPH;
    hipLaunchKernelGGL(mk_fwd, dim3(grid), dim3(NTHR), LDS_BYTES, stream, a);
}
```

```cpp
#include <hip/hip_runtime.h>
#include <cstdio>
#include <cstdint>

constexpr int DM = 2048, NCTX = 4096, NLAT = 8192, NT = NCTX + NLAT, DEPTH = 2;
constexpr int SEQC = 256, SEQL = 4096, NSEQ = 18, PAST = 512;
constexpr int INC = 4672, LDZ = 4864;
constexpr int ZQ = 0, ZFF = 512, ZFB = 1024, ZI = 1536, ZG = 2048, ZXR = 2560, ZYR = 3072, ZCQ = 3584, ZCKV = 4096, ZKPE = 4608;
constexpr int NKV = NCTX + 2 * (SEQL + PAST);
constexpr int NEXP = 16, CAPC = 512, CAPL = 1024, EROWS = CAPC + CAPL, NSLOT = NEXP * EROWS, DFF = 1024;
constexpr float ALPHA = 1.41421356237309515f;
constexpr size_t O_Y = 0, O_CKV = (size_t)NT * DM, O_KPE = O_CKV + (size_t)16 * 2 * 256 * 512, O_HG = O_KPE + (size_t)16 * 2 * 256 * 64,
                 O_RG = O_HG + (size_t)16 * 2 * 2 * 4 * 128 * 128, O_END = O_RG + (size_t)16 * 2 * 2 * 512;

typedef unsigned short bf16_t;
typedef float f32x4_t __attribute__((ext_vector_type(4)));
typedef unsigned u32x4_t __attribute__((ext_vector_type(4)));
__device__ __forceinline__ float bf2f(bf16_t b) { return __uint_as_float(((unsigned)b) << 16); }
__device__ __forceinline__ bf16_t f2bf(float f) { unsigned u = __float_as_uint(f); u += 0x7FFFu + ((u >> 16) & 1u); return (bf16_t)(u >> 16); }
__device__ __forceinline__ unsigned cvtpk2(float lo, float hi) { unsigned r; asm volatile("v_cvt_pk_bf16_f32 %0, %1, %2" : "=v"(r) : "v"(lo), "v"(hi)); return r; }
__device__ __forceinline__ float sigmoidf_(float x) { return 1.0f / (1.0f + expf(-x)); }
__device__ __forceinline__ float siluf_(float x) { return x * sigmoidf_(x); }
__device__ __forceinline__ float gelu_tanh_(float x) { const float u = 0.7978845608028654f * (x + 0.044715f * x * x * x); return x * __builtin_amdgcn_rcpf(1.0f + __expf(-2.0f * u)); }

constexpr size_t al256(size_t x) { return (x + 255) / 256 * 256; }
constexpr size_t WS_CTL = 0, CTL_BYTES = 1u << 20, CTL_ZERO = 32768;
constexpr size_t WS_MODS = WS_CTL + CTL_BYTES;
constexpr size_t WS_LB = WS_MODS + al256((size_t)2 * 3 * 6 * DM * 4);
constexpr size_t WS_ROPE = WS_LB + al256((size_t)2 * 2 * 512 * 4);
constexpr size_t WS_PROB = WS_ROPE + al256((size_t)2 * 64 * 16 * 4);
constexpr size_t WS_SLOT = WS_PROB + al256((size_t)NT * 16 * 4);
constexpr size_t WS_RIDX = WS_SLOT + al256((size_t)NT * 16 * 4);
constexpr size_t WS_GATE = WS_RIDX + al256((size_t)NSLOT * 4);
constexpr size_t WS_WIN = WS_GATE + al256((size_t)NSLOT * 4);
constexpr size_t WS_WOUT = WS_WIN + al256((size_t)2 * LDZ * DM * 2);
constexpr size_t WS_WUQ = WS_WOUT + al256((size_t)2 * DM * DM * 2);
constexpr size_t WS_WUKV = WS_WUQ + al256((size_t)2 * 1536 * 512 * 2);
constexpr size_t WS_WGU = WS_WUKV + al256((size_t)2 * 2048 * 512 * 2);
constexpr size_t WS_WD = WS_WGU + al256((size_t)2 * NEXP * 2048 * DM * 2);
constexpr size_t WS_WRG = WS_WD + al256((size_t)2 * NEXP * DM * DFF * 2);
constexpr size_t WS_RGC = WS_WRG + al256((size_t)32 * 128 * 128 * 2);
constexpr size_t WS_RT = WS_RGC + al256((size_t)3 * 2 * 192 * 512 * 4);
constexpr size_t WS_XN = WS_RT + al256((size_t)2 * 16 * DM * 4);
constexpr size_t WS_HM = WS_XN + al256((size_t)NT * DM * 4);
constexpr size_t WS_Z = WS_HM + al256((size_t)NT * DM * 2);
constexpr size_t WS_CQN = WS_Z + al256((size_t)NT * LDZ * 2);
constexpr size_t WS_CKVA = WS_CQN + al256((size_t)NT * 512 * 2);
constexpr size_t WS_KPEA = WS_CKVA + al256((size_t)NKV * 512 * 2);
constexpr size_t WS_QM = WS_KPEA + al256((size_t)NKV * 64 * 2);
constexpr size_t WS_KN = WS_QM + al256((size_t)NT * 1536 * 2);
constexpr size_t WS_VV = WS_KN + al256((size_t)NKV * 1024 * 2);
constexpr size_t WS_OMIX = WS_VV + al256((size_t)NKV * 1024 * 2);
constexpr size_t WS_XCV = WS_OMIX + al256((size_t)NT * DM * 2);
constexpr size_t WS_RGA = WS_XCV + al256((size_t)NT * 512 * 4);
constexpr size_t WS_RGX = WS_RGA + al256((size_t)2 * NT * 512 * 4);
constexpr size_t WS_RGH = WS_RGX + al256((size_t)2 * NT * 512 * 4);
constexpr size_t WS_OHG = WS_RGH + al256((size_t)2 * NT * 512 * 4);
constexpr size_t WS_QS = WS_OHG + al256((size_t)2 * NT * 512 * 4);
constexpr size_t WS_DT = WS_QS + al256((size_t)2 * NT * 512 * 2);
constexpr size_t WS_END = WS_DT + al256((size_t)2 * 192 * 4 * 128 * 4);
constexpr size_t WS_LNS = WS_DT;
constexpr size_t WS_DS = WS_RGH;
constexpr size_t WS_SST = WS_HM;
constexpr size_t WS_X1 = WS_Z;
constexpr size_t WS_HF = WS_HM;
constexpr size_t WS_XS = WS_QM;
constexpr size_t WS_HID = WS_RGA;
static_assert((size_t)NT * DM * 4 <= (size_t)NT * LDZ * 2 && WS_XS + (size_t)NSLOT * DM * 2 <= WS_XCV && (size_t)NSLOT * DFF * 2 <= (size_t)2 * NT * 512 * 4, "overlays");

#define XB_TMO      128
#define XB_XCNT(j)  (256  + 64 * (j))
#define XB_XSUB(j)  (1280 + 64 * (j))
#define XB_XGEN(j)  (2304 + 64 * (j))
#define XB_TOP      3328
#define XB_TOPGEN   3392
#define XCD_BAR_WORDS 3456
#define XB_SPIN_CAP (1u << 24)
#define LAS __attribute__((address_space(3)))
__device__ __forceinline__ unsigned xb_ld(unsigned* p)              { return __hip_atomic_load(p, __ATOMIC_RELAXED, __HIP_MEMORY_SCOPE_AGENT); }
__device__ __forceinline__ unsigned xb_add(unsigned* p, unsigned v) { return __hip_atomic_fetch_add(p, v, __ATOMIC_RELAXED, __HIP_MEMORY_SCOPE_AGENT); }
__device__ __forceinline__ unsigned xb_xcc_id() { return (unsigned)__builtin_amdgcn_s_getreg((3 << 11) | 20) & 0xFu; }
#define XB_SPIN(cond, bar) do { unsigned _sp = 0; while (cond) { __builtin_amdgcn_s_sleep(1); \
    if ((++_sp & 255u) == 0u) { if (xb_ld(&(bar)[XB_TMO])) break; if (_sp > XB_SPIN_CAP) { atomicAdd(&(bar)[XB_TMO], 1u); break; } } } } while (0)
struct XcdBarrier { unsigned* bar; unsigned x; volatile LAS unsigned* st; };
__device__ __forceinline__ XcdBarrier xcd_barrier_post(unsigned* bar, volatile LAS unsigned* st) {
    XcdBarrier b; b.bar = bar; b.x = xb_xcc_id(); b.st = st;
    if (threadIdx.x == 0) (void)xb_add(&bar[XB_XCNT(b.x)], 1u);
    return b;
}
__device__ __forceinline__ void xcd_barrier_complete(unsigned* bar, unsigned x, unsigned& nloc, unsigned& nx) {
    const unsigned G = gridDim.x * gridDim.y * gridDim.z;
    unsigned sum, cnt, mine, sp = 0u;
    for (;;) {
        sum = 0u; cnt = 0u; mine = 0u;
#pragma unroll
        for (unsigned j = 0; j < 16; ++j) { const unsigned c = xb_ld(&bar[XB_XCNT(j)]); sum += c; cnt += (c > 0u) ? 1u : 0u; mine = (j == x) ? c : mine; }
        if (sum == G) break;
        __builtin_amdgcn_s_sleep(1);
        if ((++sp & 255u) == 0u) { if (xb_ld(&bar[XB_TMO])) break; if (sp > XB_SPIN_CAP) { atomicAdd(&bar[XB_TMO], 1u); break; } }
    }
    nloc = mine > 0u ? mine : 1u; nx = cnt > 0u ? cnt : 1u;
}
__device__ __forceinline__ void xcd_barrier(const XcdBarrier& b) {
    asm volatile("s_waitcnt vmcnt(0)" ::: "memory");
    __syncthreads();
    if (threadIdx.x == 0) {
        unsigned* bar = b.bar;
        __builtin_amdgcn_s_waitcnt(0);
        unsigned nloc = b.st[0], nx = b.st[1];
        if (nloc == 0u) { xcd_barrier_complete(bar, b.x, nloc, nx); b.st[0] = nloc; b.st[1] = nx; }
        const unsigned old = xb_add(&bar[XB_XSUB(b.x)], 1u);
        const unsigned gen = old / nloc;
        if (old + 1u == (gen + 1u) * nloc) {
            __builtin_amdgcn_fence(__ATOMIC_RELEASE, "agent");
            asm volatile("s_waitcnt vmcnt(0)" ::: "memory");
            const unsigned og = xb_add(&bar[XB_TOP], 1u);
            const unsigned tg = og / nx;
            if (og + 1u == (tg + 1u) * nx) xb_add(&bar[XB_TOPGEN], 1u);
            else XB_SPIN(xb_ld(&bar[XB_TOPGEN]) == tg, bar);
            __builtin_amdgcn_fence(__ATOMIC_ACQUIRE, "agent");
            xb_add(&bar[XB_XGEN(b.x)], 1u);
            asm volatile("s_waitcnt vmcnt(0)" ::: "memory");
        } else {
            XB_SPIN(xb_ld(&bar[XB_XGEN(b.x)]) == gen, bar);
            __builtin_amdgcn_fence(__ATOMIC_ACQUIRE, "agent");
            asm volatile("s_waitcnt vmcnt(0)" ::: "memory");
        }
    }
    __syncthreads();
}

enum { I_XP = 0, I_XS, I_CCKV, I_CKPE, I_SHG, I_SRG, I_C, I_CCTX, I_WIN, I_WOUT, I_LBL, I_HGN, I_CONVW, I_CONVB, I_WR, I_BR, I_WI, I_BI, I_LAM,
       I_QNG, I_KVNG, I_WUQ, I_WUK, I_WUV, I_ADAW, I_ADAB, I_LN1G, I_LN1B, I_LN2G, I_LN2B, I_ROUT, I_WG, I_WU, I_WD, N_IN };
struct Args { const float* in[N_IN]; float* out; unsigned char* ws; int ph_lo, ph_hi; };
constexpr int NTHR = 512;
constexpr int LDS_BYTES = 163840;
constexpr int LDS_MISC = 163840 - 256;

struct F {
    const float* const* in; float* out; unsigned char* ws; unsigned char* lds; int tid, bid, nb;
    __device__ __forceinline__ float* modp(int l, int g) const { return (float*)(ws + WS_MODS) + ((size_t)l * 3 + g) * (6 * DM); }
};
#define GAS __attribute__((address_space(1)))
__device__ __forceinline__ F launder(F f) { asm volatile("" : "+v"(f.tid)); asm volatile("" : "+s"(f.bid), "+s"(f.nb)); { GAS unsigned char* gw = (GAS unsigned char*)f.ws; GAS float* go = (GAS float*)f.out; asm volatile("" : "+s"(gw), "+s"(go)); f.ws = (unsigned char*)gw; f.out = (float*)go; }
    return f; }
__device__ __forceinline__ int xcd_deal(const F& f, int k, int total) {
    if ((f.nb & 7) || (total & 7)) { const int u = f.bid + k * f.nb; return u < total ? u : -1; }
    const int per = total >> 3, W = f.nb >> 3, j = (f.bid >> 3) + k * W; return j < per ? (f.bid & 7) * per + j : -1;
}
__device__ __forceinline__ int tok_group(int t) { return t < NCTX ? 0 : 1 + ((t - NCTX) >> 12); }
__device__ __forceinline__ int seq_base(int s) { return s < 16 ? s * SEQC : NCTX + (s - 16) * SEQL; }
__device__ __forceinline__ int seq_len(int s) { return s < 16 ? SEQC : SEQL; }
__device__ __forceinline__ int kv_base(int s) { return s < 16 ? s * SEQC : NCTX + (s - 16) * (SEQL + PAST); }
__device__ __forceinline__ int kv_len(int s) { return s < 16 ? SEQC : SEQL + PAST; }
__device__ __forceinline__ int kv_row_of_tok(int t) { return t < NCTX ? t : NCTX + ((t - NCTX) >> 12) * (SEQL + PAST) + ((t - NCTX) & 4095); }

__device__ __forceinline__ float block_sum(float v, float* red, int tid) {
    for (int o = 32; o >= 1; o >>= 1) v += __shfl_xor(v, o);
    __syncthreads();
    if ((tid & 63) == 0) red[tid >> 6] = v;
    __syncthreads();
    float s = 0.f;
#pragma unroll
    for (int i = 0; i < 8; ++i) s += red[i];
    return s;
}


namespace pg8 {
#define PG8_LAS __attribute__((address_space(3)))
typedef short bf16x8 __attribute__((ext_vector_type(8)));
typedef float f32x4 __attribute__((ext_vector_type(4)));
typedef unsigned u32x4 __attribute__((ext_vector_type(4)));
constexpr int BM = 256, BK = 64, HALF = 128, HTB = HALF * BK * 2  , STAGE_BYTES = 8 * HTB, NXCD = 8, WGM = 8;

__host__ __device__ __forceinline__ int lds_byte(int r, int c) { const int st = (r >> 4) * 2 + (c >> 5), rr = r & 15, cc = c & 31, ob = rr * 64 + cc * 2; return st * 1024 + (ob ^ (((ob >> 9) & 1) << 5)); }
__host__ __device__ __forceinline__ void stage_rc(int b, int& R, int& C) { const int st = b / 1024, sb = b % 1024, swz = sb ^ (((sb >> 9) & 1) << 5); R = (st >> 1) * 16 + swz / 64; C = (st & 1) * 32 + (swz % 64) / 2; }
__host__ __device__ __forceinline__ int perm32(int rho) { const int n = rho >> 4, i = rho & 15; return 8 * (i >> 2) + 4 * n + (i & 3); }

struct Unit { int pm, pn; };
struct Gemm { const bf16_t* A; const bf16_t* Bt; int M, N, K; int mper; size_t bstride; };

struct StaticOrder {
    int nM, nN, nwg, G, c;
    __host__ __device__ void init(int M, int N, int G_, int c_) { nM = M / BM; nN = N / BM; nwg = nM * nN; G = G_; c = c_; }
    __host__ __device__ bool next(int i, Unit& u) const {
        const long L = (long)i * G + c; if (L >= nwg) return false;
        int wgid = (int)L; { const int q = nwg / NXCD, r = nwg % NXCD, xcd = wgid % NXCD, off = wgid / NXCD; wgid = (xcd < r ? xcd * (q + 1) : r * (q + 1) + (xcd - r) * q) + off; }
        const int nig = WGM * nN, gid = wgid / nig, fm = gid * WGM, gsz = (nM - fm) < WGM ? (nM - fm) : WGM;
        u.pm = fm + ((wgid % nig) % gsz); u.pn = (wgid % nig) / gsz; return true;
    }
    __device__ __forceinline__ void a_ready(const Unit&) const {}
    __device__ __forceinline__ void done(const Unit&) const {}
};
__device__ __forceinline__ unsigned cvt_pk_bf16(float lo, float hi) { unsigned r; asm volatile("v_cvt_pk_bf16_f32 %0, %1, %2" : "=v"(r) : "v"(lo), "v"(hi)); return r; }
template <class Epi, class Sched, bool STAMP = false, bool GATHER = false>
__device__ __forceinline__ void gemm_phase(PG8_LAS unsigned char* lds, const Gemm g, const Sched& S, const Epi& E, unsigned long long* stamps, const int* ridx = nullptr) {
    int tid_ = threadIdx.x; asm volatile("" : "+v"(tid_));
    const int tid = tid_, wid = __builtin_amdgcn_readfirstlane(tid >> 6), lane = tid & 63, wr = wid >> 2, wc = wid & 3, fr = lane & 15, fq = lane >> 4;
    const int K = g.K, nt = K / BK;
    int ts_lo = 0, ts_hi = 0, nts = 0; const unsigned long long rt_entry = STAMP ? (unsigned long long)wall_clock64() : 0ull;
#define PG8_STAMP() do { if (STAMP && wid == 0 && nts < 64) { const unsigned long long _c = (unsigned long long)clock64(); \
        ts_lo = (lane == nts) ? (int)(unsigned)_c : ts_lo; ts_hi = (lane == nts) ? (int)(unsigned)(_c >> 32) : ts_hi; ++nts; } } while (0)
    PG8_STAMP();
    unsigned voffA[2], voffB[2];
#pragma unroll
    for (int i = 0; i < 2; ++i) { int R, C; stage_rc(tid * 16 + i * 8192, R, C); const int Rb = Epi::PERM ? ((R & ~31) + perm32(R & 31)) : R;
        voffA[i] = (unsigned)(R * K + C) * 2u; voffB[i] = (unsigned)(Rb * K + C) * 2u; }
    const size_t kstep = (size_t)(BK * 2);
    const size_t hstep = (size_t)HALF * K * 2;
    const size_t hstepA = GATHER ? 0 : hstep;
    unsigned vgC[2][2], vgN[2][2];
#define PG8_VG(vg, pm_) do { _Pragma("unroll") for (int _h = 0; _h < 2; ++_h) _Pragma("unroll") for (int _i = 0; _i < 2; ++_i) { int R_, C_; stage_rc(tid * 16 + _i * 8192, R_, C_); \
        vg[_h][_i] = ((unsigned)ridx[(pm_) * BM + _h * HALF + R_] * (unsigned)K + (unsigned)C_) * 2u; } } while (0)
#define PG8_STAGEA(bufoff, gbase, h_, nx_) do { if (GATHER) { unsigned vo_[2]; vo_[0] = (nx_) ? vgN[h_][0] : vgC[h_][0]; vo_[1] = (nx_) ? vgN[h_][1] : vgC[h_][1]; PG8_STAGE(bufoff, gbase, vo_); } else PG8_STAGE(bufoff, (gbase) + (h_) * hstepA, voffA); } while (0)
    const size_t tstep = 2 * hstep;
    const unsigned ldsw = (unsigned)wid * 1024u;
    const int aoff = lds_byte(wr * 64 + fr, fq * 8), boff = lds_byte(wc * 32 + fr, fq * 8);
#define PG8_SA(b, h) (((b) * 2 + (h)) * HTB)
#define PG8_SB(b, h) ((4 + (b) * 2 + (h)) * HTB)
#define PG8_STAGE(bufoff, gbase, voff) do { _Pragma("unroll") for (int _i = 0; _i < 2; ++_i) \
        __builtin_amdgcn_global_load_lds((const unsigned*)((const char*)(gbase) + (voff)[_i]), (PG8_LAS unsigned*)(lds + (bufoff) + ldsw + _i * 8192), 16, 0, 0); } while (0)
#define PG8_LDA(dst, b, h) do { _Pragma("unroll") for (int m = 0; m < 4; ++m) _Pragma("unroll") for (int k = 0; k < 2; ++k) dst[m][k] = *(const PG8_LAS bf16x8*)(lds + PG8_SA(b, h) + aoff + m * 2048 + k * 1024); } while (0)
#define PG8_LDB(dst, b, h) do { _Pragma("unroll") for (int n = 0; n < 2; ++n) _Pragma("unroll") for (int k = 0; k < 2; ++k) dst[n][k] = *(const PG8_LAS bf16x8*)(lds + PG8_SB(b, h) + boff + n * 2048 + k * 1024); } while (0)
#define PG8_MMA(ai, bj, At, Bt) do { __builtin_amdgcn_s_setprio(1); _Pragma("unroll") for (int m = 0; m < 4; ++m) _Pragma("unroll") for (int n = 0; n < 2; ++n) _Pragma("unroll") for (int k = 0; k < 2; ++k) \
        acc[ai][bj][m][n] = __builtin_amdgcn_mfma_f32_16x16x32_bf16(Bt[n][k], At[m][k], acc[ai][bj][m][n], 0, 0, 0); __builtin_amdgcn_s_setprio(0); } while (0)
#define PG8_WAIT_V(n) asm volatile("s_waitcnt vmcnt(" #n ")" ::: "memory")
#define PG8_WAIT_L(n) asm volatile("s_waitcnt lgkmcnt(" #n ")" ::: "memory")
#define PG8_BAR __builtin_amdgcn_s_barrier()
#define PG8_SCHED __builtin_amdgcn_sched_barrier(0)
    Unit cur, nxt; int ui = 0;
    if (!S.next(0, cur)) return;
    f32x4 acc[2][2][4][2];
#pragma unroll
    for (int a = 0; a < 2; ++a)
#pragma unroll
        for (int b = 0; b < 2; ++b)
#pragma unroll
            for (int m = 0; m < 4; ++m)
#pragma unroll
                for (int n = 0; n < 2; ++n) acc[a][b][m][n] = (f32x4){0.f, 0.f, 0.f, 0.f};
    bf16x8 At[4][2], B0[2][2], B1[2][2];
    const char* cA = (const char*)g.A + (GATHER ? (size_t)0 : (size_t)cur.pm * tstep); if (GATHER) PG8_VG(vgC, cur.pm);
    const char* cB = (const char*)(g.Bt + (size_t)(cur.pm / g.mper) * g.bstride) + (size_t)cur.pn * tstep;
    S.a_ready(cur);
    PG8_STAGE(PG8_SB(0, 0), cB, voffB); PG8_STAGEA(PG8_SA(0, 0), cA, 0, false); PG8_STAGE(PG8_SB(0, 1), cB + hstep, voffB); PG8_STAGEA(PG8_SA(0, 1), cA, 1, false);
    if (wr == 1) PG8_BAR;
    PG8_WAIT_V(4); PG8_BAR;
    PG8_STAGE(PG8_SB(1, 0), cB + kstep, voffB); PG8_STAGEA(PG8_SA(1, 0), cA + kstep, 0, false); PG8_STAGE(PG8_SB(1, 1), cB + hstep + kstep, voffB);
    PG8_WAIT_V(6); PG8_BAR;
    PG8_STAMP();
    for (;;) {
        const bool has_next = S.next(ui + 1, nxt);
        const char* nA = (has_next && !GATHER) ? (const char*)g.A + (size_t)nxt.pm * tstep : cA; if (GATHER && has_next) PG8_VG(vgN, nxt.pm);
        const char* nB = has_next ? (const char*)(g.Bt + (size_t)(nxt.pm / g.mper) * g.bstride) + (size_t)nxt.pn * tstep : cB;
        for (int t = 0; t < nt; t += 2) {
            const bool last = (t == nt - 2);
            const char* a1 = cA + (size_t)(t + 1) * kstep;
            const char* a2 = last ? nA : cA + (size_t)(t + 2) * kstep; const char* b2 = last ? nB : cB + (size_t)(t + 2) * kstep;
            const char* a3 = a2 + kstep; const char* b3 = b2 + kstep;
            if (last && has_next) S.a_ready(nxt);
            PG8_LDB(B0, 0, 0); PG8_SCHED; PG8_LDA(At, 0, 0); PG8_STAGEA(PG8_SA(1, 1), a1, 1, false);
            PG8_WAIT_L(8); PG8_BAR; PG8_WAIT_L(0); PG8_MMA(0, 0, At, B0); PG8_BAR; PG8_SCHED;
            PG8_LDB(B1, 0, 1); PG8_STAGE(PG8_SB(0, 0), b2, voffB);
            PG8_BAR; PG8_WAIT_L(0); PG8_MMA(0, 1, At, B1); PG8_BAR;
            PG8_LDA(At, 0, 1); PG8_STAGEA(PG8_SA(0, 0), a2, 0, last && has_next);
            PG8_BAR; PG8_WAIT_L(0); PG8_MMA(1, 0, At, B0); PG8_BAR; PG8_SCHED;
            PG8_STAGE(PG8_SB(0, 1), b2 + hstep, voffB);
            PG8_WAIT_V(6); PG8_BAR; PG8_MMA(1, 1, At, B1); PG8_BAR;
            PG8_LDB(B0, 1, 0); PG8_SCHED; PG8_LDA(At, 1, 0); PG8_STAGEA(PG8_SA(0, 1), a2, 1, last && has_next);
            PG8_WAIT_L(8); PG8_BAR; PG8_WAIT_L(0); PG8_MMA(0, 0, At, B0); PG8_BAR; PG8_SCHED;
            PG8_LDB(B1, 1, 1); PG8_STAGE(PG8_SB(1, 0), b3, voffB);
            PG8_BAR; PG8_WAIT_L(0); PG8_MMA(0, 1, At, B1); PG8_BAR;
            PG8_LDA(At, 1, 1); PG8_STAGEA(PG8_SA(1, 0), a3, 0, last && has_next);
            PG8_BAR; PG8_WAIT_L(0); PG8_MMA(1, 0, At, B0); PG8_BAR; PG8_SCHED;
            PG8_STAGE(PG8_SB(1, 1), b3 + hstep, voffB);
            PG8_WAIT_V(6); PG8_BAR; PG8_MMA(1, 1, At, B1); PG8_BAR;
        }
        PG8_STAMP();
        if constexpr (!Epi::AFTER_DRAIN) { E(acc, cur, wr, wc, fr, fq); S.done(cur); }
        PG8_STAMP();
        if (!has_next) break;
#pragma unroll
        for (int a = 0; a < 2; ++a)
#pragma unroll
            for (int b = 0; b < 2; ++b)
#pragma unroll
                for (int m = 0; m < 4; ++m)
#pragma unroll
                    for (int n = 0; n < 2; ++n) acc[a][b][m][n] = (f32x4){0.f, 0.f, 0.f, 0.f};
        cur = nxt; cA = nA; cB = nB; ++ui;
        if (GATHER) { _Pragma("unroll") for (int _h = 0; _h < 2; ++_h) _Pragma("unroll") for (int _i = 0; _i < 2; ++_i) vgC[_h][_i] = vgN[_h][_i]; }
    }
    PG8_WAIT_V(0);
    if (wr == 0) PG8_BAR;
    PG8_BAR;
    if constexpr (Epi::AFTER_DRAIN) { E.fused(acc, cur, wr, wc, fr, fq, lds, wid, lane); S.done(cur); }
    PG8_STAMP();
    if (STAMP && wid == 0) { stamps[lane] = lane < nts ? (((unsigned long long)(unsigned)ts_hi << 32) | (unsigned)ts_lo) : 0ull;
        if (lane == 62) stamps[62] = rt_entry; if (lane == 63) stamps[63] = (unsigned long long)wall_clock64(); }
#undef PG8_STAMP
#undef PG8_SA
#undef PG8_SB
#undef PG8_STAGE
#undef PG8_STAGEA
#undef PG8_VG
#undef PG8_LDA
#undef PG8_LDB
#undef PG8_MMA
#undef PG8_WAIT_V
#undef PG8_WAIT_L
#undef PG8_BAR
#undef PG8_SCHED
}
}

namespace pg8 {
struct EpiB16 {
    static constexpr bool PERM = true, AFTER_DRAIN = false;
    bf16_t* O; int ldc; int split_cols; size_t split_stride;
    __device__ __forceinline__ void operator()(const f32x4 (&acc)[2][2][4][2], const Unit& u, int wr, int wc, int fr_, int fq_) const {
        int fr = fr_, fq = fq_; asm volatile("s_nop 15\n\ts_nop 15" : "+v"(fr), "+v"(fq));
        const int row0 = u.pm * BM + wr * 64 + fr; int colt = u.pn * BM; bf16_t* base = O;
        if (split_cols) { const int t = colt / split_cols; base += (size_t)t * split_stride; colt -= t * split_cols; }
        const int col0 = colt + wc * 32 + 8 * fq;
#pragma unroll
        for (int ai = 0; ai < 2; ++ai)
#pragma unroll
            for (int m = 0; m < 4; ++m) { bf16_t* rowp = base + (size_t)(row0 + ai * HALF + m * 16) * ldc + col0;
#pragma unroll
                for (int bj = 0; bj < 2; ++bj) { const f32x4 v0 = acc[ai][bj][m][0], v1 = acc[ai][bj][m][1];
                    u32x4 w; w.x = cvt_pk_bf16(v0[0], v0[1]); w.y = cvt_pk_bf16(v0[2], v0[3]); w.z = cvt_pk_bf16(v1[0], v1[1]); w.w = cvt_pk_bf16(v1[2], v1[3]);
                    *(u32x4*)(rowp + bj * HALF) = w; } }
    }
};
struct EpiOutProj {
    static constexpr bool PERM = false, AFTER_DRAIN = false;
    const float* xbase; long long dlat; const float* mods; bf16_t* pre; const bf16_t* xb16;
    __device__ __forceinline__ void operator()(const f32x4 (&acc)[2][2][4][2], const Unit& u, int wr, int wc, int fr_, int fq_) const {
        int fr = fr_, fq = fq_; asm volatile("" : "+v"(fr), "+v"(fq));
        const int trow = u.pm * BM; const int grp = trow < NCTX ? 0 : 1 + ((trow - NCTX) >> 12);
        const float* g1 = mods + (size_t)grp * 6 * DM + 2 * DM;
        const float* xb = xbase + (trow < NCTX ? 0ll : dlat) + (size_t)trow * DM;
        const int r0 = wr * 64 + fr, col0 = u.pn * BM + wc * 32 + 4 * fq;
        typedef unsigned u32x2 __attribute__((ext_vector_type(2)));
        if (xb16 == nullptr) {
#pragma unroll
        for (int ai = 0; ai < 2; ++ai)
#pragma unroll
            for (int m = 0; m < 4; ++m) { const int r = r0 + ai * HALF + m * 16; const float* xr = xb + (size_t)r * DM + col0; bf16_t* pr = pre + (size_t)(trow + r) * DM + col0;
#pragma unroll
                for (int bj = 0; bj < 2; ++bj)
#pragma unroll
                    for (int n = 0; n < 2; ++n) { const f32x4 xv = *(const f32x4*)(xr + bj * HALF + n * 16); const f32x4 gv = *(const f32x4*)(g1 + col0 + bj * HALF + n * 16);
                        const f32x4 y = xv * ALPHA + gv * acc[ai][bj][m][n]; u32x2 w; w.x = cvt_pk_bf16(y[0], y[1]); w.y = cvt_pk_bf16(y[2], y[3]);
                        *(u32x2*)(pr + bj * HALF + n * 16) = w; }
                asm volatile("" ::: "memory"); }
        } else {
#pragma unroll
        for (int ai = 0; ai < 2; ++ai)
#pragma unroll
            for (int m = 0; m < 4; ++m) { const int r = r0 + ai * HALF + m * 16; const bf16_t* xr = xb16 + (size_t)(trow + r) * DM + col0; bf16_t* pr = pre + (size_t)(trow + r) * DM + col0;
#pragma unroll
                for (int bj = 0; bj < 2; ++bj)
#pragma unroll
                    for (int n = 0; n < 2; ++n) { const u32x2 xw = *(const u32x2*)(xr + bj * HALF + n * 16); const f32x4 gv = *(const f32x4*)(g1 + col0 + bj * HALF + n * 16);
                        const f32x4 xv = {__uint_as_float(xw.x << 16), __uint_as_float(xw.x & 0xffff0000u), __uint_as_float(xw.y << 16), __uint_as_float(xw.y & 0xffff0000u)};
                        const f32x4 y = xv * ALPHA + gv * acc[ai][bj][m][n]; u32x2 w; w.x = cvt_pk_bf16(y[0], y[1]); w.y = cvt_pk_bf16(y[2], y[3]);
                        *(u32x2*)(pr + bj * HALF + n * 16) = w; }
                asm volatile("" ::: "memory"); }
        }
    }
};
struct EpiMoe1 {
    static constexpr bool PERM = true, AFTER_DRAIN = false;
    bf16_t* hid;
    __device__ __forceinline__ void operator()(const f32x4 (&acc)[2][2][4][2], const Unit& u, int wr, int wc, int fr_, int fq_) const {
        int fr = fr_, fq = fq_; asm volatile("" : "+v"(fr), "+v"(fq));
        const int row0 = u.pm * BM + wr * 64 + fr, hc0 = u.pn * (BM / 2) + wc * 16 + 4 * fq;
#pragma unroll
        for (int ai = 0; ai < 2; ++ai)
#pragma unroll
            for (int m = 0; m < 4; ++m) { bf16_t* rowp = hid + (size_t)(row0 + ai * HALF + m * 16) * DFF + hc0;
#pragma unroll
                for (int bj = 0; bj < 2; ++bj) { const f32x4 g = acc[ai][bj][m][0], uu = acc[ai][bj][m][1]; float h[4];
#pragma unroll
                    for (int j = 0; j < 4; ++j) h[j] = g[j] * __builtin_amdgcn_rcpf(1.0f + __expf(-g[j])) * uu[j];
                    typedef unsigned u32x2 __attribute__((ext_vector_type(2)));
                    u32x2 w; w.x = cvt_pk_bf16(h[0], h[1]); w.y = cvt_pk_bf16(h[2], h[3]);
                    *(u32x2*)(rowp + bj * (HALF / 2)) = w; } }
    }
};
struct EpiMoe2 {
    static constexpr bool PERM = true, AFTER_DRAIN = false;
    bf16_t* ys; const float* gate;
    __device__ __forceinline__ void operator()(const f32x4 (&acc)[2][2][4][2], const Unit& u, int wr, int wc, int fr_, int fq_) const {
        int fr = fr_, fq = fq_; asm volatile("" : "+v"(fr), "+v"(fq));
        const int row0 = u.pm * BM + wr * 64 + fr, col0 = u.pn * BM + wc * 32 + 8 * fq;
#pragma unroll
        for (int ai = 0; ai < 2; ++ai)
#pragma unroll
            for (int m = 0; m < 4; ++m) { const int r = row0 + ai * HALF + m * 16; const float gt = gate[r]; bf16_t* rowp = ys + (size_t)r * DM + col0;
#pragma unroll
                for (int bj = 0; bj < 2; ++bj) { const f32x4 v0 = acc[ai][bj][m][0] * gt, v1 = acc[ai][bj][m][1] * gt;
                    u32x4 w; w.x = cvt_pk_bf16(v0[0], v0[1]); w.y = cvt_pk_bf16(v0[2], v0[3]); w.z = cvt_pk_bf16(v1[0], v1[1]); w.w = cvt_pk_bf16(v1[2], v1[3]);
                    *(u32x4*)(rowp + bj * HALF) = w; } }
    }
};
}

#define LDS_BARRIER() do { asm volatile("s_waitcnt lgkmcnt(0)" ::: "memory"); __builtin_amdgcn_s_barrier(); asm volatile("" ::: "memory"); } while (0)
struct WTile { const float* a; long long dba; bf16_t* dst; int mode, ld, nmax, n0, k0, K; };
__device__ __forceinline__ WTile wtile_decode(const F& f, int t) {
    constexpr int T_IN = 2 * 38 * 16, T_OUT = 2 * 16 * 16, T_UQ = 2 * 12 * 4, T_UKV = 2 * 16 * 4, T_GU = 2 * 16 * 16 * 16;
    WTile w; int u = t;
    if (u < T_IN) { const int l = u / (38 * 16), r = u % (38 * 16); w.a = f.in[I_WIN] + (size_t)l * DM * INC; w.dba = 0; w.dst = (bf16_t*)(f.ws + WS_WIN) + (size_t)l * LDZ * DM; w.mode = 0; w.ld = INC; w.nmax = INC; w.n0 = (r / 16) * 128; w.k0 = (r % 16) * 128; w.K = DM; return w; }
    u -= T_IN;
    if (u < T_OUT) { const int l = u / (16 * 16), r = u % (16 * 16); w.a = f.in[I_WOUT] + (size_t)l * DM * DM; w.dba = 0; w.dst = (bf16_t*)(f.ws + WS_WOUT) + (size_t)l * DM * DM; w.mode = 0; w.ld = DM; w.nmax = DM; w.n0 = (r / 16) * 128; w.k0 = (r % 16) * 128; w.K = DM; return w; }
    u -= T_OUT;
    if (u < T_UQ) { const int l = u / (12 * 4), r = u % (12 * 4); w.a = f.in[I_WUQ] + (size_t)l * 512 * 1536; w.dba = 0; w.dst = (bf16_t*)(f.ws + WS_WUQ) + (size_t)l * 1536 * 512; w.mode = 0; w.ld = 1536; w.nmax = 1536; w.n0 = (r / 4) * 128; w.k0 = (r % 4) * 128; w.K = 512; return w; }
    u -= T_UQ;
    if (u < T_UKV) { const int l = u / (16 * 4), r = u % (16 * 4); w.a = f.in[I_WUK] + (size_t)l * 512 * 1024; w.dba = (f.in[I_WUV] + (size_t)l * 512 * 1024) - w.a; w.dst = (bf16_t*)(f.ws + WS_WUKV) + (size_t)l * 2048 * 512; w.mode = 1; w.ld = 1024; w.nmax = 2048; w.n0 = (r / 4) * 128; w.k0 = (r % 4) * 128; w.K = 512; return w; }
    u -= T_UKV;
    if (u < T_GU) { const int le = u / (16 * 16), r = u % (16 * 16); w.a = f.in[I_WG] + (size_t)le * DM * DFF; w.dba = (f.in[I_WU] + (size_t)le * DM * DFF) - w.a; w.dst = (bf16_t*)(f.ws + WS_WGU) + (size_t)le * 2048 * DM; w.mode = 2; w.ld = DFF; w.nmax = 2048; w.n0 = (r / 16) * 128; w.k0 = (r % 16) * 128; w.K = DM; return w; }
    u -= T_GU;
    { const int le = u / (16 * 8), r = u % (16 * 8); w.a = f.in[I_WD] + (size_t)le * DFF * DM; w.dba = 0; w.dst = (bf16_t*)(f.ws + WS_WD) + (size_t)le * DM * DFF; w.mode = 0; w.ld = DM; w.nmax = DM; w.n0 = (r / 8) * 128; w.k0 = (r % 8) * 128; w.K = DFF; return w; }
}
__device__ __forceinline__ void wtile_load(const WTile& w, int tid, f32x4_t (&v)[8]) {
#pragma unroll
    for (int i = 0; i < 8; ++i) { const int e = tid + i * 512, n = w.n0 + (e & 31) * 4, k = w.k0 + (e >> 5); const float* p;
        if (w.mode == 0) p = n < w.nmax ? w.a + (size_t)k * w.ld + n : nullptr;
        else if (w.mode == 1) p = w.a + (n < 1024 ? 0ll : w.dba - 1024) + (size_t)k * 1024 + n;
        else { const int j = 4 * (n >> 3); p = w.a + ((n & 4) ? w.dba : 0ll) + (size_t)k * w.ld + j; }
        v[i] = p ? __builtin_nontemporal_load((const f32x4_t*)p) : (f32x4_t){0.f, 0.f, 0.f, 0.f}; }
}
constexpr int WC_IN = 112 * 11, WC_OUT = 128 * 11;
__device__ __forceinline__ int wset_tile(int set, int k) {
    if (set == 0) { if (k < 608) return k; k -= 608; if (k < 256) return 1216 + k; k -= 256; if (k < 48) return 1728 + k; k -= 48; return 1824 + k; }
    if (set == 1) { if (k < 608) return 608 + k; k -= 608; if (k < 256) return 1472 + k; k -= 256; if (k < 48) return 1776 + k; k -= 48; if (k < 64) return 1888 + k; k -= 64; if (k < 4096) return 1952 + k; k -= 4096; return 10144 + k; }
    if (k < 4096) return 6048 + k; k -= 4096; return 12192 + k;
}
__device__ __forceinline__ void ph_wconvert(const F& f, int set, int kbeg, int kend, int first, int stride) {
    const int T_ALL = kend; first += kbeg;
    float* T = (float*)f.lds;
    const int tid = f.tid;
    f32x4_t v[8];
    int t = first;
    if (t >= T_ALL) return;
    WTile w = wtile_decode(f, wset_tile(set, t));
    wtile_load(w, tid, v);
    for (;;) {
        LDS_BARRIER();
#pragma unroll
        for (int i = 0; i < 8; ++i) { const int e = tid + i * 512, n4 = (e & 31) * 4, kk = e >> 5; *(f32x4_t*)&T[kk * 132 + (n4 ^ ((kk >> 3) << 2))] = v[i]; }
        const int tn = t + stride; const bool more = tn < T_ALL;
        WTile wn = w; if (more) { wn = wtile_decode(f, wset_tile(set, tn)); wtile_load(wn, tid, v); }
        LDS_BARRIER();
#pragma unroll
        for (int i = 0; i < 4; ++i) { const int c = tid + i * 512, kc = c & 15, nr = c >> 4;
            float x[8];
#pragma unroll
            for (int j = 0; j < 8; ++j) x[j] = T[(kc * 8 + j) * 132 + (nr ^ (kc << 2))];
            u32x4_t o; o.x = pg8::cvt_pk_bf16(x[0], x[1]); o.y = pg8::cvt_pk_bf16(x[2], x[3]); o.z = pg8::cvt_pk_bf16(x[4], x[5]); o.w = pg8::cvt_pk_bf16(x[6], x[7]);
            *(u32x4_t*)(w.dst + (size_t)(w.n0 + nr) * w.K + w.k0 + kc * 8) = o; }
        if (!more) break;
        t = tn; w = wn;
    }
    __syncthreads();
}

__device__ __forceinline__ void ph_prologue(const F& fin) {
    const F f = launder(fin);
    float* sv = (float*)f.lds;
    float* red = sv + 3 * DM;
    for (int i = f.tid; i < 3 * DM; i += NTHR) { const int g = i / DM, d = i % DM; const float c = g == 0 ? f.in[I_CCTX][d] : f.in[I_C][(g - 1) * DM + d]; sv[i] = siluf_(c); }
    __syncthreads();
    for (int u = f.bid; u < 256; u += f.nb) {
        const int l = u >> 7, cg = u & 127, dl = f.tid / 24, c4 = f.tid % 24;
        f32x4_t a0 = {0.f, 0.f, 0.f, 0.f}, a1 = a0, a2 = a0;
        if (dl < 21) {
            const float* W = f.in[I_ADAW] + (size_t)l * DM * 6 * DM + cg * 96 + c4 * 4;
#pragma unroll 7
            for (int d = dl; d < DM; d += 21) { const f32x4_t w = *(const f32x4_t*)(W + (size_t)d * 6 * DM); a0 += w * sv[d]; a1 += w * sv[DM + d]; a2 += w * sv[2 * DM + d]; }
            *(f32x4_t*)(red + (dl * 3 + 0) * 96 + c4 * 4) = a0; *(f32x4_t*)(red + (dl * 3 + 1) * 96 + c4 * 4) = a1; *(f32x4_t*)(red + (dl * 3 + 2) * 96 + c4 * 4) = a2;
        }
        __syncthreads();
        if (f.tid < 288) { const int g = f.tid / 96, c = f.tid % 96; float sum = 0.f;
            for (int k = 0; k < 21; ++k) sum += red[(k * 3 + g) * 96 + c];
            f.modp(l, g)[cg * 96 + c] = sum + f.in[I_ADAB][(size_t)l * 6 * DM + cg * 96 + c]; }
        __syncthreads();
    }
    float* lb = (float*)(f.ws + WS_LB);
    for (int i = f.bid * NTHR + f.tid; i < 2 * 512; i += f.nb * NTHR) {
        const float x0 = f.in[I_LBL][i], x1 = f.in[I_LBL][2 * 512 + i];
        lb[i] = 0.f; lb[2 * 512 + i] = 1.0f / (1.0f + expf(x0 - x1));
    }
    float* rc = (float*)(f.ws + WS_ROPE); float* rs = rc + 64 * 16;
    for (int i = f.bid * NTHR + f.tid; i < 64 * 16; i += f.nb * NTHR) {
        const int pos = i >> 4, j = i & 15; const float inv = powf(10000.0f, -(float)(2 * j) / 32.0f); const float a = (float)pos * inv;
        rc[i] = cosf(a); rs[i] = sinf(a);
    }
    __syncthreads();
}

__device__ __forceinline__ const float* xrow(const F& f, int l, int t) {
    if (l == 0) return t < NCTX ? f.in[I_XP] + (size_t)t * DM : f.in[I_XS] + (size_t)(t - NCTX) * DM;
    return (const float*)(f.ws + WS_XN) + (size_t)t * DM;
}
__device__ __forceinline__ void ph_mod(const F& fin, int l) {
    const F f = launder(fin);
    bf16_t* hm = (bf16_t*)(f.ws + WS_HM);
#pragma unroll 4
    for (int idx = f.bid * NTHR + f.tid; idx < NT * (DM / 8); idx += f.nb * NTHR) {
        const int t = idx >> 8, c = (idx & 255) * 8; const float* x = xrow(f, l, t) + c; const float* m = f.modp(l, tok_group(t));
        const f32x4_t x0 = *(const f32x4_t*)x, x1 = *(const f32x4_t*)(x + 4), s0 = *(const f32x4_t*)(m + DM + c), s1 = *(const f32x4_t*)(m + DM + c + 4), h0 = *(const f32x4_t*)(m + c), h1 = *(const f32x4_t*)(m + c + 4);
        const f32x4_t y0 = x0 * (s0 + 1.0f) + h0, y1 = x1 * (s1 + 1.0f) + h1;
        u32x4_t w = {cvtpk2(y0[0], y0[1]), cvtpk2(y0[2], y0[3]), cvtpk2(y1[0], y1[1]), cvtpk2(y1[2], y1[3])};
        *(u32x4_t*)(hm + (size_t)t * DM + c) = w;
    }
}
__device__ __forceinline__ void ph_prep(const F& fin, int l) {
    const F f = launder(fin);
    const bf16_t* z = (const bf16_t*)(f.ws + WS_Z);
    bf16_t* cqn = (bf16_t*)(f.ws + WS_CQN); bf16_t* ckva = (bf16_t*)(f.ws + WS_CKVA); bf16_t* kpea = (bf16_t*)(f.ws + WS_KPEA); bf16_t* xcv = (bf16_t*)(f.ws + WS_XCV);
    const float* rc = (const float*)(f.ws + WS_ROPE); const float* rs = rc + 64 * 16;
    const int tid = f.tid, wave = tid >> 6, lane = tid & 63, c8 = lane * 8;
    for (int t = f.bid * 8 + wave; t < NT; t += f.nb * 8) {
        const bf16_t* zr = z + (size_t)t * LDZ;
        const bool ctx = t < NCTX; const int s = ctx ? (t >> 8) : 16 + ((t - NCTX) >> 12); const int tt = t - seq_base(s), T = seq_len(s);
        const int kr = kv_row_of_tok(t);
#pragma unroll
        for (int which = 0; which < 2; ++which) {
            const u32x4_t raw = *(const u32x4_t*)(zr + (which ? ZCKV : ZCQ) + c8); const unsigned rw[4] = {raw.x, raw.y, raw.z, raw.w};
            float v[8]; float ss = 0.f;
#pragma unroll
            for (int j = 0; j < 4; ++j) { v[2 * j] = __uint_as_float(rw[j] << 16); v[2 * j + 1] = __uint_as_float(rw[j] & 0xffff0000u); ss += v[2 * j] * v[2 * j] + v[2 * j + 1] * v[2 * j + 1]; }
            for (int o = 32; o >= 1; o >>= 1) ss += __shfl_xor(ss, o);
            const float rr = rsqrtf(ss * (1.0f / 512.0f) + 1e-6f); const float* gp = (which ? f.in[I_KVNG] : f.in[I_QNG]) + l * 512 + c8;
            const f32x4_t g0 = *(const f32x4_t*)gp, g1 = *(const f32x4_t*)(gp + 4);
            const f32x4_t o0 = {v[0] * rr * g0[0], v[1] * rr * g0[1], v[2] * rr * g0[2], v[3] * rr * g0[3]}, o1 = {v[4] * rr * g1[0], v[5] * rr * g1[1], v[6] * rr * g1[2], v[7] * rr * g1[3]};
            u32x4_t w = {cvtpk2(o0[0], o0[1]), cvtpk2(o0[2], o0[3]), cvtpk2(o1[0], o1[1]), cvtpk2(o1[2], o1[3])};
            if (which == 0) *(u32x4_t*)(cqn + (size_t)t * 512 + c8) = w;
            else { *(u32x4_t*)(ckva + (size_t)kr * 512 + c8) = w;
                if (ctx) { float* op = f.out + O_CKV + ((size_t)((t >> 8) * 2 + l) * 256 + tt) * 512 + c8; *(f32x4_t*)op = o0; *(f32x4_t*)(op + 4) = o1; } }
        }
        {
            const float v = bf2f(zr[ZKPE + lane]);
            if (ctx) { kpea[(size_t)kr * 64 + lane] = f2bf(v); f.out[O_KPE + ((size_t)((t >> 8) * 2 + l) * 256 + tt) * 64 + lane] = v; }
            else {
                const int part = lane >> 5, w = lane & 31, j = w & 15; const int pos = part ? (tt & 63) : (tt >> 6);
                const float x1 = bf2f(zr[ZKPE + part * 32 + j]), x2 = bf2f(zr[ZKPE + part * 32 + 16 + j]);
                const float c = rc[pos * 16 + j], sn = rs[pos * 16 + j];
                kpea[(size_t)kr * 64 + lane] = f2bf(w < 16 ? x1 * c - x2 * sn : x2 * c + x1 * sn);
            }
        }
        {
            f32x4_t a0 = *(const f32x4_t*)(f.in[I_CONVB] + l * 512 + c8), a1 = *(const f32x4_t*)(f.in[I_CONVB] + l * 512 + c8 + 4);
#pragma unroll
            for (int k = 0; k < 4; ++k) { const int u = tt + k - 2; if (u >= 0 && u < T) {
                    const u32x4_t raw = *(const u32x4_t*)(z + (size_t)(t + k - 2) * LDZ + ZXR + c8); const float* wp = f.in[I_CONVW] + (l * 4 + k) * 512 + c8;
                    const f32x4_t w0 = *(const f32x4_t*)wp, w1 = *(const f32x4_t*)(wp + 4);
                    a0[0] += w0[0] * __uint_as_float(raw.x << 16); a0[1] += w0[1] * __uint_as_float(raw.x & 0xffff0000u); a0[2] += w0[2] * __uint_as_float(raw.y << 16); a0[3] += w0[3] * __uint_as_float(raw.y & 0xffff0000u);
                    a1[0] += w1[0] * __uint_as_float(raw.z << 16); a1[1] += w1[1] * __uint_as_float(raw.z & 0xffff0000u); a1[2] += w1[2] * __uint_as_float(raw.w << 16); a1[3] += w1[3] * __uint_as_float(raw.w & 0xffff0000u); } }
            { const u32x4_t w = {cvtpk2(a0[0], a0[1]), cvtpk2(a0[2], a0[3]), cvtpk2(a1[0], a1[1]), cvtpk2(a1[2], a1[3])}; *(u32x4_t*)(xcv + (size_t)t * 512 + c8) = w; }
        }
    }
    for (int i = f.bid * NTHR + tid; i < 2 * PAST * 512; i += f.nb * NTHR) {
        const int b = i / (PAST * 512), r = i % (PAST * 512), j = r / 512, c = r % 512;
        ckva[(size_t)(NCTX + b * (SEQL + PAST) + SEQL + j) * 512 + c] = f2bf(f.in[I_CCKV][(((size_t)b * 2 + l) * PAST + j) * 512 + c]);
    }
    for (int i = f.bid * NTHR + tid; i < 2 * PAST * 64; i += f.nb * NTHR) {
        const int b = i / (PAST * 64), r = i % (PAST * 64), j = r / 64, c = r % 64;
        kpea[(size_t)(NCTX + b * (SEQL + PAST) + SEQL + j) * 64 + c] = f2bf(f.in[I_CKPE][(((size_t)b * 2 + l) * PAST + j) * 64 + c]);
    }
}

namespace att {
using bf16x8 = __attribute__((ext_vector_type(8))) short;
using s16x4  = __attribute__((ext_vector_type(4))) short;
using f32x16 = __attribute__((ext_vector_type(16))) float;
using u32x4  = __attribute__((ext_vector_type(4))) unsigned;
constexpr int NW = 8, QBLK = 32, KVBLK = 64, DQK = 192, DV = 128, LDQ = 1536, LDK = 1024, LDP = 64, LDO = DM;
constexpr float SCALE = 0.07216878364870322f, THR = 8.f;
constexpr size_t SHM_V = KVBLK * DV * 2, SHM_K = KVBLK * DQK * 2;
#define AKSWZ(row, colB) ((row) * 384 + ((colB) ^ (((row) & 7) << 4)))
#define ASBAR() __builtin_amdgcn_sched_barrier(0)
__device__ __forceinline__ int crow(int r, int hi) { return (r & 3) + 8 * (r >> 2) + 4 * hi; }
__device__ __forceinline__ unsigned cvtpk(float lo, float hi) { unsigned r; asm volatile("v_cvt_pk_bf16_f32 %0, %1, %2" : "=v"(r) : "v"(lo), "v"(hi)); return r; }
__device__ __forceinline__ void partialSM(f32x16& p0, f32x16& p1, float& m_reg, float& mn, float& alpha) {
  constexpr float C = SCALE * 1.4426950408889634f;
  float pmax = p0[0]; for (int r = 1; r < 16; ++r) pmax = fmaxf(pmax, p0[r]); for (int r = 0; r < 16; ++r) pmax = fmaxf(pmax, p1[r]);
  { auto rr = __builtin_amdgcn_permlane32_swap(__float_as_uint(pmax), __float_as_uint(pmax), false, false);
    pmax = fmaxf(__uint_as_float(rr[0]), __uint_as_float(rr[1])); }
  if (__builtin_expect(__all(pmax - m_reg <= THR / SCALE), 1)) { mn = m_reg; alpha = 1.f; }
  else { mn = fmaxf(m_reg, pmax); alpha = __builtin_amdgcn_exp2f((m_reg - mn) * C); m_reg = mn; }
  float mnC = -mn * C;
  for (int r = 0; r < 16; ++r) p0[r] = fmaf(p0[r], C, mnC); for (int r = 0; r < 16; ++r) p1[r] = fmaf(p1[r], C, mnC);
  for (int r = 0; r < 16; ++r) p0[r] = __builtin_amdgcn_exp2f(p0[r]);
}
__device__ __forceinline__ void finishSM(f32x16& p0, f32x16& p1, float alpha, float& l_reg, bf16x8& pa0, bf16x8& pa1, bf16x8& pa2, bf16x8& pa3) {
  for (int r = 0; r < 16; ++r) p1[r] = __builtin_amdgcn_exp2f(p1[r]);
  float ps = 0; for (int r = 0; r < 16; ++r) ps += p0[r]; for (int r = 0; r < 16; ++r) ps += p1[r];
  { auto rr = __builtin_amdgcn_permlane32_swap(__float_as_uint(ps), __float_as_uint(ps), false, false);
    ps = __uint_as_float(rr[0]) + __uint_as_float(rr[1]); }
  l_reg = l_reg * alpha + ps;
#define APK4(P, BASE, OUT) do { unsigned a0 = cvtpk(P[BASE + 0], P[BASE + 1]), a1 = cvtpk(P[BASE + 2], P[BASE + 3]);   \
    unsigned b0 = cvtpk(P[BASE + 4], P[BASE + 5]), b1 = cvtpk(P[BASE + 6], P[BASE + 7]);                              \
    auto r0 = __builtin_amdgcn_permlane32_swap(a0, b0, false, false); auto r1 = __builtin_amdgcn_permlane32_swap(a1, b1, false, false); \
    u32x4 w = {r0[0], r1[0], r0[1], r1[1]}; OUT = *reinterpret_cast<bf16x8*>(&w); } while (0)
  APK4(p0, 0, pa0); APK4(p0, 8, pa1); APK4(p1, 0, pa2); APK4(p1, 8, pa3);
#undef APK4
}
__device__ __forceinline__ void qkt(f32x16& p0, f32x16& p1, const char* Ks, const bf16x8* qr, const int (&kb)[4]) {
  p0 = f32x16{}; p1 = f32x16{};
#pragma unroll
  for (int d0 = 0; d0 < 12; ++d0) { const char* ka = Ks + kb[d0 & 3] + (d0 >> 2) * 128;
    bf16x8 b0 = *reinterpret_cast<const bf16x8*>(ka);
    bf16x8 b1 = *reinterpret_cast<const bf16x8*>(ka + 12288);
    p0 = __builtin_amdgcn_mfma_f32_32x32x16_bf16(b0, qr[d0], p0, 0, 0, 0);
    p1 = __builtin_amdgcn_mfma_f32_32x32x16_bf16(b1, qr[d0], p1, 0, 0, 0); }
}
__device__ __forceinline__ int v_st(int k, int c) { const int kk = (k & ~0xC) | ((k & 4) << 1) | ((k & 8) >> 1); return ((kk >> 3) * 4 + (c >> 5)) * 512 + ((kk & 7) * 32 + (c & 31)) * 2; }
__device__ __forceinline__ int v_rd_base(int lane) { return ((lane & 3) << 3) | (((lane >> 2) & 3) << 6) | (((lane >> 4) & 1) << 5) | (((lane >> 5) & 1) << 8); }
constexpr int v_rd_off(int d0, int ks, int half) { return d0 * 512 + ks * 4096 + half * 2048; }
template <int OFF> __device__ __forceinline__ s16x4 tr_read(int vb) {
  s16x4 r; asm volatile("ds_read_b64_tr_b16 %0, %1 offset:%2" : "=&v"(r) : "v"(vb), "i"(OFF) : "memory"); return r;
}
template <int D0> __device__ __forceinline__ void pv_one(f32x16& od, int vb, bf16x8 pa0, bf16x8 pa1, bf16x8 pa2, bf16x8 pa3) {
  const s16x4 l0 = tr_read<v_rd_off(D0, 0, 0)>(vb), h0 = tr_read<v_rd_off(D0, 0, 1)>(vb), l1 = tr_read<v_rd_off(D0, 1, 0)>(vb), h1 = tr_read<v_rd_off(D0, 1, 1)>(vb);
  const s16x4 l2 = tr_read<v_rd_off(D0, 2, 0)>(vb), h2 = tr_read<v_rd_off(D0, 2, 1)>(vb), l3 = tr_read<v_rd_off(D0, 3, 0)>(vb), h3 = tr_read<v_rd_off(D0, 3, 1)>(vb);
  asm volatile("s_waitcnt lgkmcnt(0)" ::: "memory"); ASBAR();
#define APK(L, H) (bf16x8){L[0], L[1], L[2], L[3], H[0], H[1], H[2], H[3]}
  od = __builtin_amdgcn_mfma_f32_32x32x16_bf16(pa0, APK(l0, h0), od, 0, 0, 0);
  od = __builtin_amdgcn_mfma_f32_32x32x16_bf16(pa1, APK(l1, h1), od, 0, 0, 0);
  od = __builtin_amdgcn_mfma_f32_32x32x16_bf16(pa2, APK(l2, h2), od, 0, 0, 0);
  od = __builtin_amdgcn_mfma_f32_32x32x16_bf16(pa3, APK(l3, h3), od, 0, 0, 0);
#undef APK
}
__device__ __forceinline__ void pv_d0(f32x16* o, int vb, bf16x8 pa0, bf16x8 pa1, bf16x8 pa2, bf16x8 pa3) {
  pv_one<0>(o[0], vb, pa0, pa1, pa2, pa3); pv_one<1>(o[1], vb, pa0, pa1, pa2, pa3); pv_one<2>(o[2], vb, pa0, pa1, pa2, pa3); pv_one<3>(o[3], vb, pa0, pa1, pa2, pa3);
}
constexpr int V_OFF = 0, K_OFF = 3 * (int)SHM_V, WS_OFF = K_OFF + 3 * (int)SHM_K, ATT_LDS = WS_OFF + NW * 64 * 4;
#define ABAR() do { asm volatile("" ::: "memory"); __builtin_amdgcn_s_barrier(); asm volatile("" ::: "memory"); } while (0)
template <int MODE>
__device__ __forceinline__ void attn_body(const bf16_t* __restrict__ Qb, const bf16_t* __restrict__ Kn, const bf16_t* __restrict__ Kp, const bf16_t* __restrict__ Vh,
                                          bf16_t* __restrict__ Ob, int seq, int tt0, int rope, const float* __restrict__ rc, const float* __restrict__ rs, LAS unsigned char* ldsl, int tid) {
  char* lds = (char*)ldsl;
  const int wid = __builtin_amdgcn_readfirstlane(tid >> 6), lane = tid & 63, r32 = lane & 31, hi = lane >> 5;
  char* V_lds = lds + V_OFF; char* K_lds = lds + K_OFF;
  float* ws = (float*)(lds + WS_OFF) + wid * 64; float* li_l = ws; float* al_l = ws + 32;
  float m_reg = -1e30f, l_reg = 0; f32x16 o[4] = {}; bf16x8 qr[12];
  const bf16_t* Qw = Qb + (long)(wid * QBLK + r32) * LDQ + hi * 8;
#pragma unroll
  for (int d0 = 0; d0 < 12; ++d0) qr[d0] = *reinterpret_cast<const bf16x8*>(Qw + d0 * 16);
  if (rope) {
    const int tt = tt0 + wid * QBLK + r32;
#pragma unroll
    for (int part = 0; part < 2; ++part) {
      const int pos = part ? (tt & 63) : (tt >> 6);
      const float* cp = rc + pos * 16 + hi * 8; const float* sp = rs + pos * 16 + hi * 8;
      const bf16x8 x1 = qr[8 + 2 * part], x2 = qr[9 + 2 * part];
      float y1[8], y2[8];
#pragma unroll
      for (int i = 0; i < 8; ++i) { const float a = bf2f((bf16_t)x1[i]), b = bf2f((bf16_t)x2[i]), c = cp[i], sn = sp[i]; y1[i] = a * c - b * sn; y2[i] = b * c + a * sn; }
      u32x4 w1 = {cvtpk(y1[0], y1[1]), cvtpk(y1[2], y1[3]), cvtpk(y1[4], y1[5]), cvtpk(y1[6], y1[7])};
      u32x4 w2 = {cvtpk(y2[0], y2[1]), cvtpk(y2[2], y2[3]), cvtpk(y2[4], y2[5]), cvtpk(y2[6], y2[7])};
      qr[8 + 2 * part] = *reinterpret_cast<bf16x8*>(&w1); qr[9 + 2 * part] = *reinterpret_cast<bf16x8*>(&w2);
    }
  }
  int koff[3], voff[2];
#pragma unroll
  for (int i = 0; i < 3; ++i) { const int p = (wid + 8 * i) * 64 + lane, row = p / 24, slot = p % 24, ch = (slot & ~7) | ((slot ^ row) & 7);
    koff[i] = ch >= 16 ? (int)(((unsigned)(row * LDP + (ch - 16) * 8) * 2u) | 0x80000000u) : (row * LDK + ch * 8) * 2; }
#pragma unroll
  for (int i = 0; i < 2; ++i) { const int p = (wid + 8 * i) * 64 + lane, sub = p >> 5, w = p & 31, kk = (sub >> 2) * 8 + (w >> 2), k = (kk & ~0xC) | ((kk & 4) << 1) | ((kk & 8) >> 1), c = (sub & 3) * 32 + (w & 3) * 8;
    voff[i] = (k * LDK + c) * 2; }
  LAS unsigned char* const kl0 = ldsl + K_OFF + wid * 1024; LAS unsigned char* const vl0 = ldsl + V_OFF + wid * 1024;
  int dtK = 0, dtV = 0;
#define ADMA_K(b) do { if (MODE == 2) break; const char* kn_t = (const char*)Kn + (long)dtK * (KVBLK * LDK * 2); const char* kp_t = (const char*)Kp + (long)dtK * (KVBLK * LDP * 2); \
    _Pragma("unroll") for (int _i = 0; _i < 3; ++_i) { const char* src_ = (koff[_i] < 0 ? kp_t : kn_t) + (koff[_i] & 0x7fffffff); \
        __builtin_amdgcn_global_load_lds((const unsigned*)src_, (LAS unsigned*)(kl0 + (b) * (int)SHM_K + _i * 8192), 16, 0, 0); } ++dtK; } while (0)
#define ADMA_V(b) do { if (MODE == 2) break; const char* v_t = (const char*)Vh + (long)dtV * (KVBLK * LDK * 2); \
    _Pragma("unroll") for (int _i = 0; _i < 2; ++_i) __builtin_amdgcn_global_load_lds((const unsigned*)(v_t + voff[_i]), (LAS unsigned*)(vl0 + (b) * (int)SHM_V + _i * 8192), 16, 0, 0); ++dtV; } while (0)
#define AWAITN(allow) do { if ((allow) >= 10) asm volatile("s_waitcnt vmcnt(10)" ::: "memory"); else if ((allow) >= 5) asm volatile("s_waitcnt vmcnt(5)" ::: "memory"); else asm volatile("s_waitcnt vmcnt(0)" ::: "memory"); } while (0)
#define ARESC(a) do { if (__any((a) < 1.f)) { if (hi == 0) al_l[r32] = (a); asm volatile("s_waitcnt lgkmcnt(0)" ::: "memory"); \
    for (int d = 0; d < 4; ++d) for (int r = 0; r < 16; ++r) o[d][r] *= al_l[crow(r, hi)]; } } while (0)
  const int vbase = (int)(uintptr_t)V_lds + v_rd_base(lane);
  int kb[4];
#pragma unroll
  for (int b = 0; b < 4; ++b) kb[b] = AKSWZ(r32, (b * 16 + hi * 8) * 2);
  f32x16 pA0, pA1, pB0, pB1; float mnA, mnB, alA, alB; bf16x8 pa0, pa1, pa2, pa3; const int NT_ = seq / KVBLK;
  __syncthreads();
  ADMA_K(0); ADMA_V(0); ADMA_K(1); ADMA_V(1); ADMA_K(2); ADMA_V(2);
  AWAITN(10); ABAR();
  qkt(pA0, pA1, K_lds, qr, kb); partialSM(pA0, pA1, m_reg, mnA, alA);
  ABAR();
  ADMA_K(0);
  AWAITN(10); ABAR();
  int bp = 0, bc = 1, bn = 2;
  int prevn = 5;
  for (int j = 1; j + 1 < NT_; j += 2) {
    ASBAR(); qkt(pB0, pB1, K_lds + bc * (int)SHM_K, qr, kb);
    finishSM(pA0, pA1, alA, l_reg, pa0, pa1, pa2, pa3); ASBAR();
    pv_d0(o, vbase + bp * (int)SHM_V, pa0, pa1, pa2, pa3); partialSM(pB0, pB1, m_reg, mnB, alB);
    ABAR();
    int curn = 0;
    if (j + 3 < NT_) { ADMA_K(bc); curn += 3; }
    if (j + 2 < NT_) { ADMA_V(bp); curn += 2; }
    AWAITN(prevn + curn); ARESC(alB); ABAR();
    prevn = curn;
    ASBAR(); qkt(pA0, pA1, K_lds + bn * (int)SHM_K, qr, kb);
    finishSM(pB0, pB1, alB, l_reg, pa0, pa1, pa2, pa3); ASBAR();
    pv_d0(o, vbase + bc * (int)SHM_V, pa0, pa1, pa2, pa3); partialSM(pA0, pA1, m_reg, mnA, alA);
    ABAR();
    curn = 0;
    if (j + 4 < NT_) { ADMA_K(bn); curn += 3; }
    if (j + 3 < NT_) { ADMA_V(bc); curn += 2; }
    AWAITN(prevn + curn); ARESC(alA); ABAR();
    prevn = curn;
    const int t_ = bp; bp = bn; bn = bc; bc = t_;
  }
  AWAITN(0);
  ASBAR(); qkt(pB0, pB1, K_lds + bc * (int)SHM_K, qr, kb);
  finishSM(pA0, pA1, alA, l_reg, pa0, pa1, pa2, pa3); ASBAR();
  pv_d0(o, vbase + bp * (int)SHM_V, pa0, pa1, pa2, pa3); partialSM(pB0, pB1, m_reg, mnB, alB);
  ARESC(alB);
  finishSM(pB0, pB1, alB, l_reg, pa0, pa1, pa2, pa3); ASBAR();
  pv_d0(o, vbase + bc * (int)SHM_V, pa0, pa1, pa2, pa3);
  if (hi == 0) li_l[r32] = l_reg; asm volatile("s_waitcnt lgkmcnt(0)" ::: "memory");
  float rli[16];
#pragma unroll
  for (int r = 0; r < 16; ++r) rli[r] = __builtin_amdgcn_rcpf(li_l[crow(r, hi)]);
  bf16_t* Ow = Ob + (long)(wid * QBLK) * LDO;
#pragma unroll
  for (int r = 0; r < 16; ++r) { int orow = crow(r, hi);
    for (int d0 = 0; d0 < 4; ++d0) { if (MODE == 0 || o[d0][r] * rli[r] == 1.2345e30f) Ow[(long)orow * LDO + d0 * 32 + r32] = f2bf(o[d0][r] * rli[r]); } }
#undef ADMA_K
#undef ADMA_V
#undef AWAITN
#undef ARESC
}
}
template <int MODE>
__device__ __forceinline__ void attn_unit(const F& f, int s, int h, int qb) {
    const bf16_t* qm = (const bf16_t*)(f.ws + WS_QM); const bf16_t* kn = (const bf16_t*)(f.ws + WS_KN); const bf16_t* vv = (const bf16_t*)(f.ws + WS_VV);
    const bf16_t* kpea = (const bf16_t*)(f.ws + WS_KPEA); bf16_t* omix = (bf16_t*)(f.ws + WS_OMIX);
    const float* rc = (const float*)(f.ws + WS_ROPE); const float* rs = rc + 64 * 16;
    const int t0 = seq_base(s) + qb * 256, kb = kv_base(s);
    att::attn_body<MODE>(qm + (size_t)t0 * 1536 + h * 192, kn + (size_t)kb * 1024 + h * 128, kpea + (size_t)kb * 64, vv + (size_t)kb * 1024 + h * 128,
                   omix + (size_t)t0 * DM + 1024 + h * 128, kv_len(s), qb * 256, s >= 16 ? 1 : 0, rc, rs, (LAS unsigned char*)f.lds, f.tid);
}

typedef short bf16x8_t __attribute__((ext_vector_type(8)));
__device__ __forceinline__ void ph_rgw(const F& f) {
    bf16_t* wt = (bf16_t*)(f.ws + WS_WRG);
    { float* rt = (float*)(f.ws + WS_RT); for (int idx = f.bid * NTHR + f.tid; idx < 2 * 16 * DM; idx += f.nb * NTHR) { const int c = idx % DM, e = (idx / DM) & 15, l = idx / (16 * DM); rt[idx] = f.in[I_ROUT][((size_t)l * DM + c) * 16 + e]; } }
    for (int idx = f.bid * NTHR + f.tid; idx < 16 * 2 * 128 * 128; idx += f.nb * NTHR) {
        const int i = idx & 127, j = (idx >> 7) & 127, g = (idx >> 14) & 1, m = idx >> 15;
        const float* src = (g ? f.in[I_WI] : f.in[I_WR]) + (size_t)m * 16384;
        wt[idx] = f2bf(src[i * 128 + j]);
    }
}
__device__ __forceinline__ void rg_unit(const F& f, int l, int dir, int h, int tile) {
    const bf16_t* xcv = (const bf16_t*)(f.ws + WS_XCV);
    bf16_t* PP = (bf16_t*)(f.ws + WS_RGA) + (size_t)dir * NT * 512; bf16_t* HL = (bf16_t*)(f.ws + WS_RGX) + (size_t)dir * NT * 512;
    float* ATOT = (float*)(f.ws + WS_RGC) + (size_t)dir * 192 * 512; float* HEND = ATOT + 2 * 192 * 512;
    const bf16_t* wt = (const bf16_t*)(f.ws + WS_WRG) + ((size_t)((l * 2 + dir) * 4 + h)) * 2 * 16384;
    char* Wl = (char*)f.lds;
    float* XC = (float*)(f.lds + 2 * 128 * 272);
    float* WT = (float*)(f.lds + 2 * 128 * 272 + 128 * 528);
    const int tid = f.tid, wid = tid >> 6, lane = tid & 63, lr = lane & 15, lg = lane >> 4;
    __syncthreads();
#pragma unroll
    for (int i = 0; i < 8; ++i) { const int c = tid + i * 512, row = c >> 4, ch = c & 15;
        *(u32x4_t*)(Wl + row * 272 + ch * 16) = *(const u32x4_t*)(wt + (size_t)row * 128 + ch * 8); }
#pragma unroll
    for (int i = 0; i < 8; ++i) { const int c = tid + i * 512, row = c >> 5, ch = c & 31; const int tok = tile * 128 + (dir ? 127 - row : row);
        typedef unsigned u32x2_t __attribute__((ext_vector_type(2))); const u32x2_t xr = *(const u32x2_t*)(xcv + (size_t)tok * 512 + h * 128 + ch * 4);
        *(f32x4_t*)(XC + row * 132 + ch * 4) = (f32x4_t){__uint_as_float(xr.x << 16), __uint_as_float(xr.x & 0xffff0000u), __uint_as_float(xr.y << 16), __uint_as_float(xr.y & 0xffff0000u)}; }
    __syncthreads();
    bf16x8_t af[4];
#pragma unroll
    for (int ks = 0; ks < 4; ++ks) { const float* p = XC + (wid * 16 + lr) * 132 + ks * 32 + lg * 8; const f32x4_t x0 = *(const f32x4_t*)p, x1 = *(const f32x4_t*)(p + 4);
        u32x4_t w = {cvtpk2(x0[0], x0[1]), cvtpk2(x0[2], x0[3]), cvtpk2(x1[0], x1[1]), cvtpk2(x1[2], x1[3])}; af[ks] = *reinterpret_cast<bf16x8_t*>(&w); }
    f32x4_t ar[8], ai[8];
#pragma unroll
    for (int nb = 0; nb < 8; ++nb) { ar[nb] = (f32x4_t){0.f, 0.f, 0.f, 0.f}; ai[nb] = (f32x4_t){0.f, 0.f, 0.f, 0.f}; }
#pragma unroll
    for (int nb = 0; nb < 8; ++nb)
#pragma unroll
        for (int ks = 0; ks < 4; ++ks) {
            const bf16x8_t br = *(const bf16x8_t*)(Wl + (nb * 16 + lr) * 272 + (ks * 32 + lg * 8) * 2);
            const bf16x8_t bi = *(const bf16x8_t*)(Wl + (128 + nb * 16 + lr) * 272 + (ks * 32 + lg * 8) * 2);
            ar[nb] = __builtin_amdgcn_mfma_f32_16x16x32_bf16(af[ks], br, ar[nb], 0, 0, 0);
            ai[nb] = __builtin_amdgcn_mfma_f32_16x16x32_bf16(af[ks], bi, ai[nb], 0, 0, 0);
            if (ks == 3 && (nb & 1)) __builtin_amdgcn_sched_barrier(0);
        }
    const int cb = (l * 2 + dir) * 512 + h * 128;
#pragma unroll
    for (int nb = 0; nb < 8; ++nb) {
        const int c = nb * 16 + lr; const float br = f.in[I_BR][cb + c], bi = f.in[I_BI][cb + c], sp = __logf(1.0f + __expf(-f.in[I_LAM][cb + c])) * -8.0f;
        float P = 1.f, H = 0.f;
#pragma unroll
        for (int i = 0; i < 4; ++i) {
            const float xc = XC[(wid * 16 + lg * 4 + i) * 132 + c];
            const float r = __builtin_amdgcn_rcpf(1.0f + __expf(-(ar[nb][i] + br))), ig = __builtin_amdgcn_rcpf(1.0f + __expf(-(ai[nb][i] + bi)));
            const float la = sp * r, a = __expf(la), x = __builtin_amdgcn_sqrtf(fmaxf(1.0f - a * a, 0.f)) * (ig * xc);
            P *= a; H = a * H + x; ar[nb][i] = P; ai[nb][i] = H;
        }
        float cA = 1.f, cH = 0.f, tA = 1.f, tH = 0.f;
#pragma unroll
        for (int g = 0; g < 4; ++g) { const float gA = __shfl(P, lr + 16 * g), gH = __shfl(H, lr + 16 * g);
            if (g < lg) { cH = gA * cH + gH; cA *= gA; }
            tH = gA * tH + gH; tA *= gA; }
#pragma unroll
        for (int i = 0; i < 4; ++i) { ai[nb][i] += ar[nb][i] * cH; ar[nb][i] *= cA; }
        if (lg == 0) { WT[(wid * 128 + nb * 16 + lr) * 2] = tA; WT[(wid * 128 + nb * 16 + lr) * 2 + 1] = tH; }
    }
    __syncthreads();
    const int w0 = wid & 4;
#pragma unroll
    for (int nb = 0; nb < 8; ++nb) {
        const int c = nb * 16 + lr; float cA = 1.f, cH = 0.f;
        for (int w = w0; w < wid; ++w) { const float gA = WT[(w * 128 + c) * 2], gH = WT[(w * 128 + c) * 2 + 1]; cH = gA * cH + gH; cA *= gA; }
#pragma unroll
        for (int i = 0; i < 4; ++i) {
            const int pos = wid * 16 + lg * 4 + i;
            const float Hf = ai[nb][i] + ar[nb][i] * cH, Pf = ar[nb][i] * cA;
            *(bf16_t*)(Wl + pos * 272 + c * 2) = f2bf(Pf); *(bf16_t*)(Wl + 128 * 272 + pos * 272 + c * 2) = f2bf(Hf);
            if ((wid & 3) == 3 && lg == 3 && i == 3) { const int tok = tile * 128 + (dir ? 127 - pos : pos); const int chunk = tok >> 6; ATOT[(size_t)chunk * 512 + h * 128 + c] = Pf; HEND[(size_t)chunk * 512 + h * 128 + c] = Hf; }
        }
    }
    __syncthreads();
#pragma unroll
    for (int i = 0; i < 8; ++i) { const int c = tid + i * 512, arr = c >> 11, r = c & 2047, row = r >> 4, ch = r & 15; const int tok = tile * 128 + (dir ? 127 - row : row);
        *(u32x4_t*)((arr ? HL : PP) + (size_t)tok * 512 + h * 128 + ch * 8) = *(const u32x4_t*)(Wl + arr * 128 * 272 + row * 272 + ch * 16); }
}
__device__ __forceinline__ void rg_passB(const F& f, int l, int idx) {
    const int c = idx & 511, dir = (idx >> 9) & 1, s = idx >> 10;
    const float* ATOT = (const float*)(f.ws + WS_RGC) + (size_t)dir * 192 * 512; const float* HEND = ATOT + 2 * 192 * 512; float* CIN = (float*)(f.ws + WS_RGC) + (size_t)(4 + dir) * 192 * 512;
    const int c0 = seq_base(s) >> 6, n = seq_len(s) >> 6;
    float hcar = s >= 16 ? f.in[I_SRG][(((size_t)(s - 16) * 2 + l) * 2 + dir) * 512 + c] : 0.f;
#pragma unroll 8
    for (int k = 0; k < n; ++k) { const int ch = c0 + (dir ? n - 1 - k : k); CIN[(size_t)ch * 512 + c] = hcar; hcar = ATOT[(size_t)ch * 512 + c] * hcar + HEND[(size_t)ch * 512 + c]; }
    if (s < 16) f.out[O_RG + (((size_t)s * 2 + l) * 2 + dir) * 512 + c] = hcar;
}
__device__ __forceinline__ void rg_passC(const F& f) {
    const bf16_t* z = (const bf16_t*)(f.ws + WS_Z); bf16_t* omix = (bf16_t*)(f.ws + WS_OMIX);
    const bf16_t* PP = (const bf16_t*)(f.ws + WS_RGA); const bf16_t* HL = (const bf16_t*)(f.ws + WS_RGX); const float* CIN = (const float*)(f.ws + WS_RGC) + (size_t)4 * 192 * 512;
    typedef unsigned u32x2_t __attribute__((ext_vector_type(2)));
#pragma unroll 3
    for (int idx = f.bid * NTHR + f.tid; idx < NT * 128; idx += f.nb * NTHR) {
        const int t = idx >> 7, c4 = (idx & 127) * 4, chunk = t >> 6;
        const u32x2_t pfr = *(const u32x2_t*)(PP + (size_t)t * 512 + c4), hfr = *(const u32x2_t*)(HL + (size_t)t * 512 + c4);
        const u32x2_t pbr = *(const u32x2_t*)(PP + (size_t)NT * 512 + (size_t)t * 512 + c4), hbr = *(const u32x2_t*)(HL + (size_t)NT * 512 + (size_t)t * 512 + c4);
        const f32x4_t cf = *(const f32x4_t*)(CIN + (size_t)chunk * 512 + c4), cbk = *(const f32x4_t*)(CIN + (size_t)(192 + chunk) * 512 + c4);
#define U2F(r) (f32x4_t){__uint_as_float((r).x << 16), __uint_as_float((r).x & 0xffff0000u), __uint_as_float((r).y << 16), __uint_as_float((r).y & 0xffff0000u)}
        const f32x4_t hsum = (U2F(hfr) + U2F(pfr) * cf) + (U2F(hbr) + U2F(pbr) * cbk);
#undef U2F
        const u32x2_t yr = *(const u32x2_t*)(z + (size_t)t * LDZ + ZYR + c4);
        u32x2_t w; w.x = cvtpk2(hsum[0] * gelu_tanh_(__uint_as_float(yr.x << 16)), hsum[1] * gelu_tanh_(__uint_as_float(yr.x & 0xffff0000u))); w.y = cvtpk2(hsum[2] * gelu_tanh_(__uint_as_float(yr.y << 16)), hsum[3] * gelu_tanh_(__uint_as_float(yr.y & 0xffff0000u)));
        *(u32x2_t*)(omix + (size_t)t * DM + 512 + c4) = w;
    }
}

__device__ __forceinline__ void ph_rg_units(const F& fin, int l) {
    const F f = launder(fin);
    for (int k = 0;; ++k) { const int u = xcd_deal(f, k, 2 * 4 * 96); if (u < 0) break; const int tile = u >> 3, dh = u & 7; rg_unit(f, l, dh >> 2, dh & 3, tile); }
    __syncthreads();
}

namespace hg {
constexpr int QP_OFF = 0, KP_OFF = 17408, KT_OFF = 34816, VT_OFF = 53248, DEC_OFF = 71680, CL_OFF = 73728, ST_OFF = 75776, LDS_END = ST_OFF + 8 * 4352;
typedef float f32x4 __attribute__((ext_vector_type(4)));
typedef short bf16x8 __attribute__((ext_vector_type(8)));
typedef short bf16x4 __attribute__((ext_vector_type(4)));
typedef unsigned u32x2 __attribute__((ext_vector_type(2)));
typedef unsigned u32x4 __attribute__((ext_vector_type(4)));
__device__ __forceinline__ void hg_zload(const F& f, int u, u32x4 (&zr)[6]) {
    const bf16_t* z = (const bf16_t*)(f.ws + WS_Z); const int tile = u % 192, dh = u / 192, dir = dh >> 2, h = dh & 3, zf = dir ? ZFB : ZFF;
#pragma unroll
    for (int i = 0; i < 6; ++i) { const int c = f.tid + i * 512, which = c >> 10, r = c & 1023, row = r >> 4, ch = r & 15;
        zr[i] = *(const u32x4*)(z + (size_t)(tile * 64 + row) * LDZ + (which == 0 ? ZQ : which == 1 ? zf : ZI) + h * 128 + ch * 8); }
}
__device__ __forceinline__ void passA(const F& f, int l, int dir, int h, int tile, u32x4 (&zr)[6], int nu) {
    const bf16_t* z = (const bf16_t*)(f.ws + WS_Z);
    const float lbv = ((const float*)(f.ws + WS_LB))[(l * 2 + dir) * 512 + h * 128 + (f.tid & 127)];
    bf16_t* QS = (bf16_t*)(f.ws + WS_QS) + (size_t)dir * NT * 512; bf16_t* OL = (bf16_t*)(f.ws + WS_OHG) + (size_t)dir * NT * 512;
    float* DT = (float*)(f.ws + WS_DT) + ((size_t)(dir * 192 + tile) * 4 + h) * 128;
    bf16_t* DS = (bf16_t*)(f.ws + WS_DS) + ((size_t)(dir * 192 + tile) * 4 + h) * 16384;
    char* L = (char*)f.lds;
    const int tid = f.tid, wid = tid >> 6, lane = tid & 63, lr = lane & 15, lg = lane >> 4;
    const int zf = dir ? ZFB : ZFF;
    __syncthreads();
    {
        char* ZS = L + ST_OFF;
#pragma unroll
        for (int i = 0; i < 6; ++i) { const int c = tid + i * 512, which = c >> 10, r = c & 1023, row = r >> 4, ch = r & 15; *(u32x4*)(ZS + which * 16384 + row * 256 + ch * 16) = zr[i]; }
        if (nu >= 0) hg_zload(f, nu, zr);
        LDS_BARRIER();
        const int d = tid & 127, q4 = tid >> 7;
        float ev[16], kv[16], qv[16]; float cum = 0.f;
#pragma unroll
        for (int i = 0; i < 16; ++i) {
            const int pos = q4 * 16 + i, trow = dir ? 63 - pos : pos; const bf16_t* zr = (const bf16_t*)(ZS + trow * 256) + d;
            const float fv = lbv + (1.0f - lbv) * __builtin_amdgcn_rcpf(1.0f + __expf(-bf2f(zr[8192])));
            cum += __logf(fv); ev[i] = cum; kv[i] = 1.0f - fv; const float qz = bf2f(zr[0]); qv[i] = qz * __builtin_amdgcn_rcpf(1.0f + __expf(-qz));
            *(bf16_t*)(L + VT_OFF + d * 144 + pos * 2) = zr[16384];
        }
        const float cl = cum;
        ((float*)(L + CL_OFF))[q4 * 128 + d] = cl; ((float*)(L + DEC_OFF))[q4 * 128 + d] = __expf(cl);
#pragma unroll
        for (int i = 0; i < 16; ++i) { const int pos = q4 * 16 + i; const float E = __expf(ev[i]), Einv = fminf(__builtin_amdgcn_rcpf(E), 5.5e34f);
            *(bf16_t*)(L + QP_OFF + pos * 272 + d * 2) = f2bf(qv[i] * E);
            *(bf16_t*)(L + KP_OFF + pos * 272 + d * 2) = f2bf(kv[i] * Einv);
            *(bf16_t*)(L + KT_OFF + d * 144 + pos * 2) = f2bf(kv[i] * __expf(cl - ev[i]));
            qv[i] *= E; }
        __syncthreads();
        float off = 0.f;
        for (int p = 0; p < q4; ++p) off += ((const float*)(L + CL_OFF))[p * 128 + d];
        const float eoff = __expf(off);
#pragma unroll
        for (int i = 0; i < 16; ++i) { const int pos = q4 * 16 + i, tok = tile * 64 + (dir ? 63 - pos : pos); QS[(size_t)tok * 512 + h * 128 + d] = f2bf(qv[i] * eoff); }
        if (q4 == 3) DT[d] = __expf(off + cl);
    }
    char* STw = L + ST_OFF + wid * 4352;
    f32x4 Sacc[8];
#pragma unroll
    for (int mb = 0; mb < 8; ++mb) Sacc[mb] = (f32x4){0.f, 0.f, 0.f, 0.f};
#pragma unroll
    for (int q4 = 0; q4 < 4; ++q4) {
        bf16x8 qf[4], kf[4];
#pragma unroll
        for (int ks = 0; ks < 4; ++ks) { qf[ks] = *(const bf16x8*)(L + QP_OFF + (q4 * 16 + lr) * 272 + (ks * 32 + lg * 8) * 2); kf[ks] = *(const bf16x8*)(L + KP_OFF + (q4 * 16 + lr) * 272 + (ks * 32 + lg * 8) * 2); }
        f32x4 at = (f32x4){0.f, 0.f, 0.f, 0.f};
#pragma unroll
        for (int ks = 0; ks < 4; ++ks) at = __builtin_amdgcn_mfma_f32_16x16x32_bf16(kf[ks], qf[ks], at, 0, 0, 0);
#pragma unroll
        for (int i = 0; i < 4; ++i) at[i] = (4 * lg + i <= lr) ? at[i] : 0.f;
        u32x4 pw = {cvtpk2(at[0], at[1]), cvtpk2(at[2], at[3]), 0u, 0u}; const bf16x8 pfrag = *reinterpret_cast<bf16x8*>(&pw);
        const u32x2 vv2 = *(const u32x2*)(L + VT_OFF + (wid * 16 + lr) * 144 + (q4 * 16 + lg * 4) * 2);
        u32x4 vw = {vv2.x, vv2.y, 0u, 0u}; const bf16x8 vfrag = *reinterpret_cast<bf16x8*>(&vw);
        f32x4 oacc = __builtin_amdgcn_mfma_f32_16x16x32_bf16(pfrag, vfrag, (f32x4){0.f, 0.f, 0.f, 0.f}, 0, 0, 0);
        if (q4 > 0) {
#pragma unroll
            for (int ks = 0; ks < 4; ++ks) { const bf16x8 sf = *(const bf16x8*)(STw + lr * 272 + (ks * 32 + lg * 8) * 2); oacc = __builtin_amdgcn_mfma_f32_16x16x32_bf16(qf[ks], sf, oacc, 0, 0, 0); }
        }
#pragma unroll
        for (int i = 0; i < 4; ++i) { const int pos = q4 * 16 + lg * 4 + i, tok = tile * 64 + (dir ? 63 - pos : pos); OL[(size_t)tok * 512 + h * 128 + wid * 16 + lr] = f2bf(oacc[i]); }
        bf16x8 bfr = (bf16x8){0, 0, 0, 0, 0, 0, 0, 0};
        if (lg < 2) bfr = *(const bf16x8*)(L + VT_OFF + (wid * 16 + lr) * 144 + (q4 * 16 + lg * 8) * 2);
#pragma unroll
        for (int mb = 0; mb < 8; ++mb) {
            bf16x8 afr = (bf16x8){0, 0, 0, 0, 0, 0, 0, 0};
            if (lg < 2) afr = *(const bf16x8*)(L + KT_OFF + (mb * 16 + lr) * 144 + (q4 * 16 + lg * 8) * 2);
            const f32x4 dc = *(const f32x4*)(L + DEC_OFF + (q4 * 128 + mb * 16 + lg * 4) * 4);
            Sacc[mb] = __builtin_amdgcn_mfma_f32_16x16x32_bf16(afr, bfr, Sacc[mb] * dc, 0, 0, 0);
        }
        if (q4 < 3) {
            __builtin_amdgcn_sched_barrier(0); asm volatile("s_nop 15\n\ts_nop 15" ::: "memory"); __builtin_amdgcn_sched_barrier(0);
#pragma unroll
            for (int mb = 0; mb < 8; ++mb) { u32x2 w; w.x = cvtpk2(Sacc[mb][0], Sacc[mb][1]); w.y = cvtpk2(Sacc[mb][2], Sacc[mb][3]); *(u32x2*)(STw + lr * 272 + (mb * 16 + lg * 4) * 2) = w; }
            asm volatile("s_waitcnt lgkmcnt(0)" ::: "memory");
        }
    }
    __builtin_amdgcn_sched_barrier(0); asm volatile("s_nop 15\n\ts_nop 15" ::: "memory"); __builtin_amdgcn_sched_barrier(0);
#pragma unroll
    for (int mb = 0; mb < 8; ++mb) { u32x2 w; w.x = cvtpk2(Sacc[mb][0], Sacc[mb][1]); w.y = cvtpk2(Sacc[mb][2], Sacc[mb][3]); *(u32x2*)(DS + (size_t)(wid * 16 + lr) * 128 + mb * 16 + lg * 4) = w; }
}
__device__ __forceinline__ void passB(const F& f, int l, int s, int h, int dir, int qd) {
    const int tid = f.tid, e = qd * 32 + (tid >> 4), d0 = (tid & 15) * 8;
    const int c0 = seq_base(s) >> 6, n = seq_len(s) >> 6;
    float S[8];
    if (s >= 16) { const float* s0 = f.in[I_SHG] + ((((size_t)(s - 16) * 2 + l) * 2 + dir) * 4 + h) * 16384 + e;
#pragma unroll
        for (int j = 0; j < 8; ++j) S[j] = s0[(size_t)(d0 + j) * 128]; }
    else {
#pragma unroll
        for (int j = 0; j < 8; ++j) S[j] = 0.f; }
    const bf16_t* dsb = (const bf16_t*)(f.ws + WS_DS) + (size_t)e * 128 + d0; const float* dtb = (const float*)(f.ws + WS_DT) + d0; bf16_t* ssb = (bf16_t*)(f.ws + WS_SST) + (size_t)e * 128 + d0;
    u32x4 dsA[4], dsB[4]; f32x4 tA[4][2], tB[4][2];
#define HGB_LOAD(DSV, TV, kb) do { _Pragma("unroll") for (int q = 0; q < 4; ++q) { const int kk = (kb) + q; const size_t ubq = ((size_t)(dir * 192 + c0 + (dir ? n - 1 - kk : kk)) * 4 + h); \
        DSV[q] = *(const u32x4*)(dsb + ubq * 16384); TV[q][0] = *(const f32x4*)(dtb + ubq * 128); TV[q][1] = *(const f32x4*)(dtb + ubq * 128 + 4); } } while (0)
#define HGB_STEP(DSV, TV, kb) do { _Pragma("unroll") for (int q = 0; q < 4; ++q) { const int kk = (kb) + q; const size_t ubq = ((size_t)(dir * 192 + c0 + (dir ? n - 1 - kk : kk)) * 4 + h); \
        u32x4 w = {cvtpk2(S[0], S[1]), cvtpk2(S[2], S[3]), cvtpk2(S[4], S[5]), cvtpk2(S[6], S[7])}; *(u32x4*)(ssb + ubq * 16384) = w; \
        const unsigned dw[4] = {DSV[q].x, DSV[q].y, DSV[q].z, DSV[q].w}; const float tv[8] = {TV[q][0][0], TV[q][0][1], TV[q][0][2], TV[q][0][3], TV[q][1][0], TV[q][1][1], TV[q][1][2], TV[q][1][3]}; \
        _Pragma("unroll") for (int j = 0; j < 4; ++j) { S[2 * j] = tv[2 * j] * S[2 * j] + __uint_as_float(dw[j] << 16); S[2 * j + 1] = tv[2 * j + 1] * S[2 * j + 1] + __uint_as_float(dw[j] & 0xffff0000u); } } } while (0)
    HGB_LOAD(dsA, tA, 0);
    for (int k = 0; k < n; k += 8) {
        if (k + 4 < n) HGB_LOAD(dsB, tB, k + 4);
        HGB_STEP(dsA, tA, k);
        if (k + 4 < n) { if (k + 8 < n) HGB_LOAD(dsA, tA, k + 8); HGB_STEP(dsB, tB, k + 4); }
    }
#undef HGB_LOAD
#undef HGB_STEP
    if (s < 16) { float* so = f.out + O_HG + ((((size_t)s * 2 + l) * 2 + dir) * 4 + h) * 16384 + e;
#pragma unroll
        for (int j = 0; j < 8; ++j) so[(size_t)(d0 + j) * 128] = S[j]; }
}
__device__ __forceinline__ void hgc_load(const F& f, int u, u32x4 (&cr)[10]) {
    const int tile = u >> 2, h = u & 3, tid = f.tid;
#pragma unroll
    for (int i = 0; i < 2; ++i) { const int c = tid + i * 512, row = c >> 4, ch = c & 15; const bf16_t* p = (const bf16_t*)(f.ws + WS_OHG) + (size_t)(tile * 64 + row) * 512 + h * 128 + ch * 8;
        cr[2 * i] = *(const u32x4*)p; cr[2 * i + 1] = *(const u32x4*)(p + (size_t)NT * 512); }
#pragma unroll
    for (int i = 0; i < 2; ++i) { const int c = tid + i * 512, row = c >> 4, ch = c & 15; cr[4 + i] = *(const u32x4*)((const bf16_t*)(f.ws + WS_Z) + (size_t)(tile * 64 + row) * LDZ + ZG + h * 128 + ch * 8); }
#pragma unroll
    for (int i = 0; i < 4; ++i) { const int c = tid + i * 512, dir = c >> 10, r = c & 1023, row = r >> 4, ch = r & 15;
        cr[6 + i] = *(const u32x4*)((const bf16_t*)(f.ws + WS_QS) + (size_t)dir * NT * 512 + (size_t)(tile * 64 + row) * 512 + h * 128 + ch * 8); }
}
__device__ __forceinline__ void passC(const F& f, int l, int tile, int h, u32x4 (&cr)[10], int nu) {
    bf16_t* omix = (bf16_t*)(f.ws + WS_OMIX);
    char* L = (char*)f.lds;
    float* OS = (float*)L;
    bf16_t* GZ = (bf16_t*)(L + 64 * 132 * 4);
    float* red = (float*)(L + 64 * 132 * 4 + 64 * 256);
    char* QL = L + 64 * 132 * 4 + 64 * 256 + 2048;
    const int tid = f.tid, wid = tid >> 6, lane = tid & 63, lr = lane & 15, lg = lane >> 4;
    const int ecol = h * 128 + wid * 16 + lr;
    bf16x8 sf[2][4];
#pragma unroll
    for (int dir = 0; dir < 2; ++dir) { const bf16_t* sst = (const bf16_t*)(f.ws + WS_SST) + ((size_t)(dir * 192 + tile) * 4 + h) * 16384 + (size_t)(wid * 16 + lr) * 128;
#pragma unroll
        for (int ks = 0; ks < 4; ++ks) sf[dir][ks] = *(const bf16x8*)(sst + ks * 32 + lg * 8); }
    LDS_BARRIER();
#pragma unroll
    for (int i = 0; i < 2; ++i) { const int c = tid + i * 512, row = c >> 4, ch = c & 15;
        const u32x4 a = cr[2 * i], b = cr[2 * i + 1]; const unsigned aw[4] = {a.x, a.y, a.z, a.w}, bw[4] = {b.x, b.y, b.z, b.w};
#pragma unroll
        for (int j = 0; j < 4; ++j) { OS[row * 132 + ch * 8 + 2 * j] = __uint_as_float(aw[j] << 16) + __uint_as_float(bw[j] << 16); OS[row * 132 + ch * 8 + 2 * j + 1] = __uint_as_float(aw[j] & 0xffff0000u) + __uint_as_float(bw[j] & 0xffff0000u); } }
#pragma unroll
    for (int i = 0; i < 2; ++i) { const int c = tid + i * 512, row = c >> 4, ch = c & 15; *(u32x4*)(GZ + row * 128 + ch * 8) = cr[4 + i]; }
#pragma unroll
    for (int i = 0; i < 4; ++i) { const int c = tid + i * 512, dir = c >> 10, r = c & 1023, row = r >> 4, ch = r & 15; *(u32x4*)(QL + (dir * 64 + row) * 272 + ch * 16) = cr[6 + i]; }
    if (nu >= 0) hgc_load(f, nu, cr);
    LDS_BARRIER();
    f32x4 acc[4];
#pragma unroll
    for (int mb = 0; mb < 4; ++mb) acc[mb] = (f32x4){0.f, 0.f, 0.f, 0.f};
#pragma unroll
    for (int dir = 0; dir < 2; ++dir) {
        const char* qs = QL + (dir * 64 + lr) * 272;
#pragma unroll
        for (int mb = 0; mb < 4; ++mb)
#pragma unroll
            for (int ks = 0; ks < 4; ++ks) { const bf16x8 qf = *(const bf16x8*)(qs + mb * 16 * 272 + (ks * 32 + lg * 8) * 2); acc[mb] = __builtin_amdgcn_mfma_f32_16x16x32_bf16(qf, sf[dir][ks], acc[mb], 0, 0, 0); }
    }
    LDS_BARRIER();
#pragma unroll
    for (int mb = 0; mb < 4; ++mb)
#pragma unroll
        for (int i = 0; i < 4; ++i) { acc[mb][i] += OS[(mb * 16 + lg * 4 + i) * 132 + wid * 16 + lr];
            float v = acc[mb][i] * acc[mb][i]; v += __shfl_xor(v, 1); v += __shfl_xor(v, 2); v += __shfl_xor(v, 4); v += __shfl_xor(v, 8);
            if (lr == 0) red[wid * 64 + mb * 16 + lg * 4 + i] = v; }
    LDS_BARRIER();
    const float gn = f.in[I_HGN][l * 512 + ecol];
#pragma unroll
    for (int mb = 0; mb < 4; ++mb)
#pragma unroll
        for (int i = 0; i < 4; ++i) { const int tl = mb * 16 + lg * 4 + i, tok = tile * 64 + tl; float ss = 0.f;
#pragma unroll
            for (int w = 0; w < 8; ++w) ss += red[w * 64 + tl];
            const float gz = bf2f(GZ[tl * 128 + wid * 16 + lr]);
            omix[(size_t)tok * DM + ecol] = f2bf(acc[mb][i] * rsqrtf(ss * (1.0f / 128.0f) + 1e-6f) * gn * (gz * __builtin_amdgcn_rcpf(1.0f + __expf(-gz)))); }
}
}
__device__ __forceinline__ void ph_hg_passA(const F& fin, int l) {
    const F f = launder(fin);
    hg::u32x4 zr[6];
    { int v = xcd_deal(f, 0, 2 * 4 * 192); if (v >= 0) hg::hg_zload(f, (v >> 3) + 192 * (v & 7), zr);
      for (int k = 0; v >= 0; ++k) { const int vn = xcd_deal(f, k + 1, 2 * 4 * 192); const int tile = v >> 3, dh = v & 7; hg::passA(f, l, dh >> 2, dh & 3, tile, zr, vn >= 0 ? (vn >> 3) + 192 * (vn & 7) : -1); v = vn; } }
    __syncthreads();
}
__device__ __forceinline__ void ph_scan(const F& fin, int l) {
    const F f = launder(fin);
    constexpr int NB_HG = 18 * 4 * 2 * 4, NB_RG = 36, NB_PRE = NB_HG + NB_RG;
    for (int u = f.bid; u < NB_PRE; u += f.nb) {
        if (u < NB_HG) { const int qd = u & 3, dir = (u >> 2) & 1, h = (u >> 3) & 3, s = 17 - (u >> 5); hg::passB(f, l, s, h, dir, qd); }
        else { const int idx = (u - NB_HG) * NTHR + f.tid; if (idx < NSEQ * 1024) rg_passB(f, l, idx); }
    }
    const bool conv_first = (f.bid & 1) != 0;
    if (conv_first) ph_wconvert(f, l + 1, WC_IN + WC_OUT, l == 0 ? 7120 : 6144, f.bid, f.nb);
    for (int c = (f.bid + f.nb - NB_PRE % f.nb) % f.nb; c < 256 + 128; c += f.nb) {
        if (c < 256) { const int u = (c & 7) * 32 + (c >> 3); attn_unit<0>(f, 16 + (u >> 7), (u >> 4) & 7, u & 15); }
        else { const int v = c - 256; attn_unit<0>(f, v >> 3, v & 7, 0); }
    }
#ifdef PROBE_ATT
    for (int c = (f.bid + f.nb - NB_PRE % f.nb) % f.nb; c < 256 + 128; c += f.nb) {
        if (c < 256) { const int u = (c & 7) * 32 + (c >> 3); attn_unit<PROBE_ATT>(f, 16 + (u >> 7), (u >> 4) & 7, u & 15); }
        else { const int v = c - 256; attn_unit<PROBE_ATT>(f, v >> 3, v & 7, 0); }
    }
#endif
    __syncthreads();
    if (!conv_first) ph_wconvert(f, l + 1, WC_IN + WC_OUT, l == 0 ? 7120 : 6144, f.bid, f.nb);
}
__device__ __forceinline__ void ph_mixfin2(const F& fin, int l) {
    const F f = launder(fin);
    { hg::u32x4 cr[10]; int u = xcd_deal(f, 0, 192 * 4); if (u >= 0) hg::hgc_load(f, u, cr);
      for (int k = 0; u >= 0; ++k) { const int un = xcd_deal(f, k + 1, 192 * 4); hg::passC(f, l, u >> 2, u & 3, cr, un); u = un; }
      __syncthreads(); }
    rg_passC(f);
}
__device__ __forceinline__ void ph_ln1(const F& fin, int l) {
    const F f = launder(fin);
    bf16_t* x1 = (bf16_t*)(f.ws + WS_X1); bf16_t* hf = (bf16_t*)(f.ws + WS_HF); float* probsT = (float*)(f.ws + WS_PROB);
    const float* g = f.in[I_LN1G] + l * DM; const float* b = f.in[I_LN1B] + l * DM;
    const int wave = f.tid >> 6, lane = f.tid & 63, r = lane & 15, kq = lane >> 4, cb = wave * 256 + kq * 8;
    float* SP = (float*)f.lds;
    float* LP = SP + 2 * 8 * 16 * 2;
    bf16x8_t bh[8], bl[8];
    { const float* rt = (const float*)(f.ws + WS_RT) + ((size_t)l * 16 + r) * DM + cb;
#pragma unroll
      for (int s = 0; s < 8; ++s) { const f32x4_t w0 = *(const f32x4_t*)(rt + 32 * s), w1 = *(const f32x4_t*)(rt + 32 * s + 4); const float w[8] = {w0[0], w0[1], w0[2], w0[3], w1[0], w1[1], w1[2], w1[3]};
          u32x4_t hi, lo;
#pragma unroll
          for (int j = 0; j < 4; ++j) { const unsigned hp = cvtpk2(w[2 * j], w[2 * j + 1]); hi[j] = hp; lo[j] = cvtpk2(w[2 * j] - __uint_as_float(hp << 16), w[2 * j + 1] - __uint_as_float(hp & 0xffff0000u)); }
          bh[s] = __builtin_bit_cast(bf16x8_t, hi); bl[s] = __builtin_bit_cast(bf16x8_t, lo); } }
    __syncthreads();
    const int par = 0;
    u32x4_t xw[8];
    { const unsigned ro = ((unsigned)((f.bid * 16 < NT ? f.bid * 16 : 0) + r) * DM + cb) * 2u;
#pragma unroll
      for (int s = 0; s < 8; ++s) xw[s] = *(const u32x4_t*)((const unsigned char*)x1 + ro + 64 * s); }
    for (int T0 = f.bid * 16; T0 < NT; T0 += f.nb * 16) {
        const unsigned ro = ((unsigned)(T0 + r) * DM + cb) * 2u;
        const float* m = f.modp(l, tok_group(T0));
        u32x4_t xn[8];
        { const int Tn = T0 + f.nb * 16 < NT ? T0 + f.nb * 16 : T0; const unsigned rn = ((unsigned)(Tn + r) * DM + cb) * 2u;
#pragma unroll
          for (int s = 0; s < 8; ++s) xn[s] = *(const u32x4_t*)((const unsigned char*)x1 + rn + 64 * s); }
        float s1 = 0.f, s2 = 0.f;
#pragma unroll
        for (int s = 0; s < 8; ++s)
#pragma unroll
            for (int j = 0; j < 4; ++j) { const float a = __uint_as_float(xw[s][j] << 16), c = __uint_as_float(xw[s][j] & 0xffff0000u); s1 += a + c; s2 += a * a + c * c; }
        s1 += __shfl_xor(s1, 16); s2 += __shfl_xor(s2, 16); s1 += __shfl_xor(s1, 32); s2 += __shfl_xor(s2, 32);
        if (kq == 0) { float* p = SP + ((par * 8 + wave) * 16 + r) * 2; p[0] = s1; p[1] = s2; }
        LDS_BARRIER();
#pragma unroll
        for (int s = 0; s < 8; ++s) asm volatile("" : "+v"(xw[s]));
        float t1 = 0.f, t2 = 0.f;
#pragma unroll
        for (int w = 0; w < 8; ++w) { const float* p = SP + ((par * 8 + w) * 16 + r) * 2; t1 += p[0]; t2 += p[1]; }
        const float mu = t1 * (1.0f / DM), rstd = rsqrtf(fmaxf(t2 * (1.0f / DM) - mu * mu, 0.f) + 1e-5f);
        if (wave == 0 && kq == 0) { float* st = (float*)(f.ws + WS_LNS) + 2 * (T0 + r); st[0] = mu; st[1] = rstd; }
        f32x4_t acc = {0.f, 0.f, 0.f, 0.f};
#pragma unroll
        for (int s = 0; s < 8; ++s) {
            const int c = cb + 32 * s;
            const f32x4_t g0 = *(const f32x4_t*)(g + c), g1 = *(const f32x4_t*)(g + c + 4), b0 = *(const f32x4_t*)(b + c), b1 = *(const f32x4_t*)(b + c + 4);
            const f32x4_t c0 = *(const f32x4_t*)(m + 4 * DM + c), c1 = *(const f32x4_t*)(m + 4 * DM + c + 4), h0 = *(const f32x4_t*)(m + 3 * DM + c), h1 = *(const f32x4_t*)(m + 3 * DM + c + 4);
            const float gv[8] = {g0[0], g0[1], g0[2], g0[3], g1[0], g1[1], g1[2], g1[3]}, bv[8] = {b0[0], b0[1], b0[2], b0[3], b1[0], b1[1], b1[2], b1[3]};
            const float cv[8] = {c0[0], c0[1], c0[2], c0[3], c1[0], c1[1], c1[2], c1[3]}, hv[8] = {h0[0], h0[1], h0[2], h0[3], h1[0], h1[1], h1[2], h1[3]};
            u32x4_t ho, lo;
#pragma unroll
            for (int j = 0; j < 4; ++j) {
                const float xa = __uint_as_float(xw[s][j] << 16), xb = __uint_as_float(xw[s][j] & 0xffff0000u);
                const float ya = (xa - mu) * rstd * gv[2 * j] + bv[2 * j], yb = (xb - mu) * rstd * gv[2 * j + 1] + bv[2 * j + 1];
                const float ha = ya * (cv[2 * j] + 1.0f) + hv[2 * j], hb = yb * (cv[2 * j + 1] + 1.0f) + hv[2 * j + 1];
                const unsigned hp = cvtpk2(ha, hb); ho[j] = hp; lo[j] = cvtpk2(ha - __uint_as_float(hp << 16), hb - __uint_as_float(hp & 0xffff0000u));
            }
            *(u32x4_t*)((unsigned char*)hf + ro + 64 * s) = ho;
            const bf16x8_t ah = __builtin_bit_cast(bf16x8_t, ho), al = __builtin_bit_cast(bf16x8_t, lo);
            acc = __builtin_amdgcn_mfma_f32_16x16x32_bf16(ah, bh[s], acc, 0, 0, 0);
            acc = __builtin_amdgcn_mfma_f32_16x16x32_bf16(ah, bl[s], acc, 0, 0, 0);
            acc = __builtin_amdgcn_mfma_f32_16x16x32_bf16(al, bh[s], acc, 0, 0, 0);
        }
#pragma unroll
        for (int j = 0; j < 4; ++j) LP[((par * 8 + wave) * 16 + kq * 4 + j) * 16 + r] = acc[j];
        LDS_BARRIER();
        if (f.tid < 256) {
            const int tok = f.tid >> 4, e = f.tid & 15; float v = 0.f;
#pragma unroll
            for (int w = 0; w < 8; ++w) v += LP[((par * 8 + w) * 16 + tok) * 16 + e];
            float mx = v; mx = fmaxf(mx, __shfl_xor(mx, 1)); mx = fmaxf(mx, __shfl_xor(mx, 2)); mx = fmaxf(mx, __shfl_xor(mx, 4)); mx = fmaxf(mx, __shfl_xor(mx, 8));
            const float ex = expf(v - mx); float sm = ex; sm += __shfl_xor(sm, 1); sm += __shfl_xor(sm, 2); sm += __shfl_xor(sm, 4); sm += __shfl_xor(sm, 8);
            probsT[(size_t)e * NT + T0 + tok] = ex / sm;
        }
#pragma unroll
        for (int s = 0; s < 8; ++s) xw[s] = xn[s];
    }
}
template <int KPT>
__device__ __forceinline__ void select_unit(const F& f, int set, int e) {
    const float* probsT = (const float*)(f.ws + WS_PROB); int* slot = (int*)(f.ws + WS_SLOT); int* ridx = (int*)(f.ws + WS_RIDX); float* gate = (float*)(f.ws + WS_GATE);
    unsigned* hist = (unsigned*)f.lds;
    unsigned* ctl = hist + 256;
    unsigned* wsum = ctl + 8;
    const int tid = f.tid, wave = tid >> 6, lane = tid & 63;
    const int j0 = set ? NCTX : 0, cap = set ? CAPL : CAPC;
    unsigned key[KPT];
    { const float* src = probsT + (size_t)e * NT + j0 + tid * KPT;
#pragma unroll
      for (int j = 0; j < KPT; j += 4) { const f32x4_t p = *(const f32x4_t*)(src + j); key[j] = __float_as_uint(p[0]); key[j + 1] = __float_as_uint(p[1]); key[j + 2] = __float_as_uint(p[2]); key[j + 3] = __float_as_uint(p[3]); } }
    unsigned prefix = 0u, mask = 0u, remaining = (unsigned)cap;
#pragma unroll 1
    for (int pass = 3; pass >= 0; --pass) {
        __syncthreads();
        if (tid < 256) hist[tid] = 0u;
        __syncthreads();
#pragma unroll
        for (int j = 0; j < KPT; ++j) if ((key[j] & mask) == prefix) atomicAdd(&hist[(key[j] >> (8 * pass)) & 255u], 1u);
        __syncthreads();
        if (wave == 0) {
            const unsigned h0 = hist[4 * lane], h1 = hist[4 * lane + 1], h2 = hist[4 * lane + 2], h3 = hist[4 * lane + 3];
            const unsigned tot = h0 + h1 + h2 + h3; unsigned suf = tot;
            for (int o = 1; o < 64; o <<= 1) { const unsigned v = __shfl_down(suf, o); if (lane + o < 64) suf += v; }
            const unsigned above = suf - tot;
            const unsigned s3 = above + h3, s2 = s3 + h2, s1 = s2 + h1, s0 = s1 + h0;
            if (s3 >= remaining && above < remaining) { ctl[0] = 4 * lane + 3; ctl[1] = remaining - above; }
            else if (s2 >= remaining && s3 < remaining) { ctl[0] = 4 * lane + 2; ctl[1] = remaining - s3; }
            else if (s1 >= remaining && s2 < remaining) { ctl[0] = 4 * lane + 1; ctl[1] = remaining - s2; }
            else if (s0 >= remaining && s1 < remaining) { ctl[0] = 4 * lane; ctl[1] = remaining - s1; }
        }
        __syncthreads();
        prefix |= ctl[0] << (8 * pass); mask |= 255u << (8 * pass); remaining = ctl[1];
    }
    const unsigned T = prefix, take_eq = remaining, cnt_gt = (unsigned)cap - take_eq;
    unsigned cg = 0u, ce = 0u;
#pragma unroll
    for (int j = 0; j < KPT; ++j) { cg += key[j] > T ? 1u : 0u; ce += key[j] == T ? 1u : 0u; }
    unsigned packed = (cg << 16) | ce, inc = packed;
    for (int o = 1; o < 64; o <<= 1) { const unsigned v = __shfl_up(inc, o); if (lane >= o) inc += v; }
    __syncthreads();
    if (lane == 63) wsum[wave] = inc;
    __syncthreads();
    unsigned base = 0u;
    for (int w = 0; w < wave; ++w) base += wsum[w];
    unsigned excl = base + inc - packed; unsigned pg = excl >> 16, pe = excl & 0xffffu;
    const int row0 = e * EROWS + (set ? CAPC : 0);
#pragma unroll
    for (int j = 0; j < KPT; ++j) {
        const int t = j0 + tid * KPT + j; int row = -1;
        if (key[j] > T) { row = row0 + (int)pg; ++pg; }
        else if (key[j] == T) { if (pe < take_eq) row = row0 + (int)(cnt_gt + pe); ++pe; }
        slot[(size_t)t * 16 + e] = row;
        if (row >= 0) { ridx[row] = t; gate[row] = __uint_as_float(key[j]); }
    }
}
__device__ __forceinline__ void ph_select(const F& fin) {
    const F f = launder(fin);
    for (int u = f.bid; u < 32; u += f.nb) { if (u < 16) select_unit<16>(f, 1, u); else select_unit<8>(f, 0, u - 16); }
    __syncthreads();
}
__device__ __forceinline__ void ln2_fill(const F& f, int l) {
    float* PL = (float*)f.lds;
    { const int ln_ = l + 1 < DEPTH ? l + 1 : l; __syncthreads();
      for (int i = f.tid; i < 13 * DM / 4; i += NTHR) { const int v = i / (DM / 4), c = (i % (DM / 4)) * 4; const float* src;
          if (v < 3) src = f.modp(l, v) + 5 * DM; else if (v == 3) src = f.in[I_LN2G] + l * DM; else if (v == 4) src = f.in[I_LN2B] + l * DM; else if (v < 8) src = f.modp(ln_, v - 5) + DM; else if (v < 11) src = f.modp(ln_, v - 8); else if (v == 11) src = f.in[I_LN1G] + l * DM; else src = f.in[I_LN1B] + l * DM;
          *(f32x4_t*)(PL + v * DM + c) = *(const f32x4_t*)(src + c); }
      __syncthreads(); }
}
__device__ __forceinline__ void ph_ln2(const F& fin, int l) {
    const F f = launder(fin);
    const bf16_t* x1 = (const bf16_t*)(f.ws + WS_X1); const bf16_t* ys = (const bf16_t*)(f.ws + WS_XS); const int* slot = (const int*)(f.ws + WS_SLOT);
    float* xo = f.out + O_Y; bf16_t* xnb = (bf16_t*)(f.ws + WS_XN); bf16_t* hm = (bf16_t*)(f.ws + WS_HM);
    const int wave = f.tid >> 6, lane = f.tid & 63;
    float* PL = (float*)f.lds;
    const float* g = PL + 3 * DM; const float* b = PL + 4 * DM;
    const int tfirst = f.bid * 8 + wave, tstr = f.nb * 8;
    typedef float f32x2_t __attribute__((ext_vector_type(2))); const f32x2_t* lns = (const f32x2_t*)(f.ws + WS_LNS); const float* g1v = PL + 11 * DM; const float* b1v = PL + 12 * DM;
    int sl = -1; u32x4_t xr[4]; f32x2_t st;
    { const int tc = tfirst < NT ? tfirst : 0; sl = lane < 16 ? slot[(size_t)tc * 16 + lane] : -1; st = lns[tc];
#pragma unroll
      for (int i = 0; i < 4; ++i) xr[i] = *(const u32x4_t*)(x1 + (size_t)tc * DM + i * 512 + lane * 8); }
    for (int t = tfirst; t < NT; t += tstr) {
        const int grp = tok_group(t); const float* m = PL + grp * DM - 5 * DM;
        const int tnx = t + tstr < NT ? t + tstr : t;
        const int sln = lane < 16 ? slot[(size_t)tnx * 16 + lane] : -1; const f32x2_t stn = lns[tnx];
        u32x4_t xrn[4];
#pragma unroll
        for (int i = 0; i < 4; ++i) xrn[i] = *(const u32x4_t*)(x1 + (size_t)tnx * DM + i * 512 + lane * 8);
        float acc[4][8];
#pragma unroll
        for (int i = 0; i < 4; ++i)
#pragma unroll
            for (int j = 0; j < 8; ++j) acc[i][j] = 0.f;
        unsigned long long msk = __ballot(sl >= 0);
        while (msk) {
            const int e0 = __builtin_ctzll(msk); msk &= msk - 1; const int r0 = __shfl(sl, e0);
            int r1 = -1; if (msk) { const int e1 = __builtin_ctzll(msk); msk &= msk - 1; r1 = __shfl(sl, e1); }
            u32x4_t ra[4], rb[4];
#pragma unroll
            for (int i = 0; i < 4; ++i) { ra[i] = *(const u32x4_t*)(ys + (size_t)r0 * DM + i * 512 + lane * 8); rb[i] = r1 >= 0 ? *(const u32x4_t*)(ys + (size_t)r1 * DM + i * 512 + lane * 8) : (u32x4_t){0u, 0u, 0u, 0u}; }
#pragma unroll
            for (int i = 0; i < 4; ++i) { const unsigned wa[4] = {ra[i].x, ra[i].y, ra[i].z, ra[i].w}, wb[4] = {rb[i].x, rb[i].y, rb[i].z, rb[i].w};
#pragma unroll
                for (int j = 0; j < 4; ++j) { acc[i][2 * j] += __uint_as_float(wa[j] << 16) + __uint_as_float(wb[j] << 16); acc[i][2 * j + 1] += __uint_as_float(wa[j] & 0xffff0000u) + __uint_as_float(wb[j] & 0xffff0000u); } }
        }
        float v[4][8]; float s1 = 0.f;
#pragma unroll
        for (int i = 0; i < 4; ++i) { const int c = i * 512 + lane * 8; const f32x4_t ga = *(const f32x4_t*)(m + 5 * DM + c), gb = *(const f32x4_t*)(m + 5 * DM + c + 4);
            const unsigned xw[4] = {xr[i].x, xr[i].y, xr[i].z, xr[i].w}; float xf[8];
#pragma unroll
            for (int j = 0; j < 4; ++j) { xf[2 * j] = __uint_as_float(xw[j] << 16); xf[2 * j + 1] = __uint_as_float(xw[j] & 0xffff0000u); }
            { const f32x4_t ga1 = *(const f32x4_t*)(g1v + c), gb1 = *(const f32x4_t*)(g1v + c + 4), ba1 = *(const f32x4_t*)(b1v + c), bb1 = *(const f32x4_t*)(b1v + c + 4);
#pragma unroll
              for (int j = 0; j < 4; ++j) { xf[j] = (xf[j] - st[0]) * st[1] * ga1[j] + ba1[j]; xf[4 + j] = (xf[4 + j] - st[0]) * st[1] * gb1[j] + bb1[j]; } }
#pragma unroll
            for (int j = 0; j < 4; ++j) { v[i][j] = ALPHA * xf[j] + ga[j] * acc[i][j]; v[i][4 + j] = ALPHA * xf[4 + j] + gb[j] * acc[i][4 + j]; s1 += v[i][j] + v[i][4 + j]; } }
        for (int o = 32; o >= 1; o >>= 1) s1 += __shfl_xor(s1, o);
        const float mu = s1 * (1.0f / DM); float qq = 0.f;
#pragma unroll
        for (int i = 0; i < 4; ++i)
#pragma unroll
            for (int j = 0; j < 8; ++j) { v[i][j] -= mu; qq += v[i][j] * v[i][j]; }
        for (int o = 32; o >= 1; o >>= 1) qq += __shfl_xor(qq, o);
        const float rstd = rsqrtf(qq * (1.0f / DM) + 1e-5f);
        const float* mn = PL + (8 + grp) * DM;
        const float* mnsc = PL + (5 + grp) * DM;
#pragma unroll
        for (int i = 0; i < 4; ++i) { const int c = i * 512 + lane * 8; const f32x4_t ga = *(const f32x4_t*)(g + c), gb = *(const f32x4_t*)(g + c + 4), ba = *(const f32x4_t*)(b + c), bb = *(const f32x4_t*)(b + c + 4);
            f32x4_t ya, yb;
#pragma unroll
            for (int j = 0; j < 4; ++j) { ya[j] = v[i][j] * rstd * ga[j] + ba[j]; yb[j] = v[i][4 + j] * rstd * gb[j] + bb[j]; }
            if (l + 1 >= DEPTH) { *(f32x4_t*)(xo + (size_t)t * DM + c) = ya; *(f32x4_t*)(xo + (size_t)t * DM + c + 4) = yb; }
            else { const u32x4_t wx = {cvtpk2(ya[0], ya[1]), cvtpk2(ya[2], ya[3]), cvtpk2(yb[0], yb[1]), cvtpk2(yb[2], yb[3])}; *(u32x4_t*)(xnb + (size_t)t * DM + c) = wx; }
            if (l + 1 < DEPTH) { const f32x4_t sa = *(const f32x4_t*)(mnsc + c), sb = *(const f32x4_t*)(mnsc + c + 4), ha = *(const f32x4_t*)(mn + c), hb = *(const f32x4_t*)(mn + c + 4);
                const f32x4_t ma = ya * (sa + 1.0f) + ha, mb = yb * (sb + 1.0f) + hb;
                u32x4_t w = {cvtpk2(ma[0], ma[1]), cvtpk2(ma[2], ma[3]), cvtpk2(mb[0], mb[1]), cvtpk2(mb[2], mb[3])};
                *(u32x4_t*)(hm + (size_t)t * DM + c) = w; } }
        sl = sln; st = stn;
#pragma unroll
        for (int i = 0; i < 4; ++i) xr[i] = xrn[i];
    }
}

#define PG8_LDS(f) ((PG8_LAS unsigned char*)(f).lds)
__device__ __forceinline__ void ph_inproj(const F& fin, int l) {
    const F f = launder(fin);
    pg8::Gemm g{(const bf16_t*)(f.ws + WS_HM), (const bf16_t*)(f.ws + WS_WIN) + (size_t)l * LDZ * DM, NT, LDZ, DM, 1 << 20, 0};
    pg8::StaticOrder S; S.init(NT, LDZ, f.nb, f.bid);
    pg8::EpiB16 E{(bf16_t*)(f.ws + WS_Z), LDZ, 0, 0};
    pg8::gemm_phase<pg8::EpiB16, pg8::StaticOrder, false>(PG8_LDS(f), g, S, E, nullptr);
    if (f.bid >= 144) ph_wconvert(f, l + 1, 0, WC_IN, f.bid - 144, 112);
}
__device__ __forceinline__ void ph_up(const F& fin, int l) {
    const F f = launder(fin);
    { pg8::Gemm g{(const bf16_t*)(f.ws + WS_CKVA), (const bf16_t*)(f.ws + WS_WUKV) + (size_t)l * 2048 * 512, NKV, 2048, 512, 1 << 20, 0};
      pg8::StaticOrder S; S.init(NKV, 2048, f.nb, f.bid);
      pg8::EpiB16 E{(bf16_t*)(f.ws + WS_KN), 1024, 1024, (size_t)(WS_VV - WS_KN) / 2};
      pg8::gemm_phase<pg8::EpiB16, pg8::StaticOrder, false>(PG8_LDS(f), g, S, E, nullptr); }
    { pg8::Gemm g{(const bf16_t*)(f.ws + WS_CQN), (const bf16_t*)(f.ws + WS_WUQ) + (size_t)l * 1536 * 512, NT, 1536, 512, 1 << 20, 0};
      pg8::StaticOrder S; S.init(NT, 1536, f.nb, (f.bid + 96) % f.nb);
      pg8::EpiB16 E{(bf16_t*)(f.ws + WS_QM), 1536, 0, 0};
      pg8::gemm_phase<pg8::EpiB16, pg8::StaticOrder, false>(PG8_LDS(f), g, S, E, nullptr); }
}
__device__ __forceinline__ void ph_outproj(const F& fin, int l) {
    const F f = launder(fin);
    pg8::Gemm g{(const bf16_t*)(f.ws + WS_OMIX), (const bf16_t*)(f.ws + WS_WOUT) + (size_t)l * DM * DM, NT, DM, DM, 1 << 20, 0};
    pg8::StaticOrder S; S.init(NT, DM, f.nb, f.bid);
    const float* xbase = l == 0 ? f.in[I_XP] : (const float*)(f.ws + WS_XN);
    const long long dlat = l == 0 ? (long long)(f.in[I_XS] - f.in[I_XP]) - (long long)NCTX * DM : 0ll;
    pg8::EpiOutProj E{xbase, dlat, (const float*)(f.ws + WS_MODS) + (size_t)l * 3 * 6 * DM, (bf16_t*)(f.ws + WS_X1), l == 0 ? (const bf16_t*)nullptr : (const bf16_t*)(f.ws + WS_XN)};
    pg8::gemm_phase<pg8::EpiOutProj, pg8::StaticOrder, false>(PG8_LDS(f), g, S, E, nullptr);
    if (f.bid >= 128) ph_wconvert(f, l + 1, WC_IN, WC_IN + WC_OUT, f.bid - 128, 128);
}
__device__ __forceinline__ void ph_moe1(const F& fin, int l) {
    const F f = launder(fin);
    pg8::Gemm g{(const bf16_t*)(f.ws + WS_HF), (const bf16_t*)(f.ws + WS_WGU) + (size_t)l * NEXP * 2048 * DM, NSLOT, 2048, DM, EROWS / 256, (size_t)2048 * DM};
    pg8::StaticOrder S; S.init(NSLOT, 2048, f.nb, f.bid);
    pg8::EpiMoe1 E{(bf16_t*)(f.ws + WS_HID)};
    pg8::gemm_phase<pg8::EpiMoe1, pg8::StaticOrder, false, true>(PG8_LDS(f), g, S, E, nullptr, (const int*)(f.ws + WS_RIDX));
}
__device__ __forceinline__ void ph_moe2(const F& fin, int l) {
    const F f = launder(fin);
    pg8::Gemm g{(const bf16_t*)(f.ws + WS_HID), (const bf16_t*)(f.ws + WS_WD) + (size_t)l * NEXP * DM * DFF, NSLOT, DM, DFF, EROWS / 256, (size_t)DM * DFF};
    pg8::StaticOrder S; S.init(NSLOT, DM, f.nb, f.bid);
    pg8::EpiMoe2 E{(bf16_t*)(f.ws + WS_XS), (const float*)(f.ws + WS_GATE)};
    pg8::gemm_phase<pg8::EpiMoe2, pg8::StaticOrder, false>(PG8_LDS(f), g, S, E, nullptr);
    ln2_fill(launder(f), l);
}

constexpr int PH_PER_LAYER = 12, NPH = 1 + DEPTH * PH_PER_LAYER;
__global__ void __launch_bounds__(NTHR, 2) mk_fwd(Args a) {
    extern __shared__ __attribute__((aligned(16))) unsigned char lds[];
    F f; f.in = a.in; f.out = a.out; f.ws = a.ws; f.lds = lds; f.tid = threadIdx.x; f.bid = blockIdx.x; f.nb = gridDim.x;
    volatile LAS unsigned* misc = (volatile LAS unsigned*)((LAS unsigned char*)lds + LDS_MISC);
    if (f.tid < 32) misc[f.tid] = 0u;
    __syncthreads();
    XcdBarrier bar = xcd_barrier_post((unsigned*)(a.ws + WS_CTL) + 4096, misc + 8);
    const int lo = a.ph_lo, hi = a.ph_hi;
#ifdef REPEAT_PH
#ifndef REPEAT_N
#define REPEAT_N 1
#endif
#define PHASE(k, call) do { if (lo <= (k) && (k) < hi) { if (((k) == 0 ? 0 : ((k) - 1) % PH_PER_LAYER + 1) == REPEAT_PH) { for (int rep_ = 0; rep_ < REPEAT_N; ++rep_) { call; xcd_barrier(bar); } } call; if ((k) + 1 < hi) xcd_barrier(bar); } } while (0)
#elif defined(ONLYPH)
#define PHASE(k, call) do { if (((k) == 0 ? 0 : ((k) - 1) % PH_PER_LAYER + 1) == ONLYPH) { if (lo <= (k) && (k) < hi) { call; if ((k) + 1 < hi) xcd_barrier(bar); } } } while (0)
#else
#define PHASE(k, call) do { if (lo <= (k) && (k) < hi) { call; if ((k) + 1 < hi) xcd_barrier(bar); } } while (0)
#endif
    PHASE(0, { ph_prologue(f); ph_rgw(launder(f)); { const F fl = launder(f); ph_wconvert(fl, 0, 0, 976, fl.bid, fl.nb); } });
    for (int l = 0; l < DEPTH; ++l) {
        const int p = 1 + l * PH_PER_LAYER;
        if (l == 0) PHASE(p + 0, ph_mod(f, l));
        PHASE(p + 1, ph_inproj(f, l));
        PHASE(p + 2, ph_prep(f, l));
        PHASE(p + 3, { ph_up(f, l); ph_rg_units(f, l); ph_hg_passA(f, l); });
        PHASE(p + 4, ph_scan(f, l));
        PHASE(p + 5, ph_mixfin2(f, l));
        PHASE(p + 6, ph_outproj(f, l));
        PHASE(p + 7, ph_ln1(f, l));
        PHASE(p + 8, ph_select(f));
        PHASE(p + 9, ph_moe1(f, l));
        PHASE(p + 10, ph_moe2(f, l));
        PHASE(p + 11, ph_ln2(f, l));
    }
#undef PHASE
}

extern "C" void kernel_launch(void* const* d_in, const int* in_sizes, int n_in, void* d_out, int out_size, void* d_ws, size_t ws_size, hipStream_t stream) {
    static int grid = 0;
    if (grid == 0) {
        if (n_in != N_IN || (size_t)out_size != O_END || ws_size < WS_END) { fprintf(stderr, "kernel_launch: shape mismatch n_in %d out %d ws %zu (need %zu)\n", n_in, out_size, ws_size, (size_t)WS_END); grid = -1; return; }
        int dev = 0, cus = 0, per_cu = 0;
        if (hipGetDevice(&dev) != hipSuccess || hipDeviceGetAttribute(&cus, hipDeviceAttributeMultiprocessorCount, dev) != hipSuccess) { grid = -1; return; }
        if (hipFuncSetAttribute((const void*)mk_fwd, hipFuncAttributeMaxDynamicSharedMemorySize, LDS_BYTES) != hipSuccess) { fprintf(stderr, "kernel_launch: hipFuncSetAttribute failed\n"); grid = -1; return; }
        if (hipOccupancyMaxActiveBlocksPerMultiprocessor(&per_cu, (const void*)mk_fwd, NTHR, LDS_BYTES) != hipSuccess || per_cu < 1) { fprintf(stderr, "kernel_launch: occupancy query says %d\n", per_cu); }
        (void)hipGetLastError();
        grid = cus;
    }
    if (grid < 0) return;
    if (hipMemsetAsync((char*)d_ws + WS_CTL, 0, CTL_ZERO, stream) != hipSuccess) return;
    Args a{};
    for (int i = 0; i < N_IN; ++i) a.in[i] = (const float*)d_in[i];
    a.out = (float*)d_out; a.ws = (unsigned char*)d_ws; a.ph_lo = 0; a.ph_hi = NPH;
    hipLaunchKernelGGL(mk_fwd, dim3(grid), dim3(NTHR), LDS_BYTES, stream, a);
}
```

```cpp
#include <hip/hip_runtime.h>
#include <cstdio>
#include <cstdint>

constexpr int DM = 2048, NCTX = 4096, NLAT = 8192, NT = NCTX + NLAT, DEPTH = 2;
constexpr int SEQC = 256, SEQL = 4096, NSEQ = 18, PAST = 512;
constexpr int INC = 4672, LDZ = 4864;
constexpr int ZQ = 0, ZFF = 512, ZFB = 1024, ZI = 1536, ZG = 2048, ZXR = 2560, ZYR = 3072, ZCQ = 3584, ZCKV = 4096, ZKPE = 4608;
constexpr int NKV = NCTX + 2 * (SEQL + PAST);
constexpr int NEXP = 16, CAPC = 512, CAPL = 1024, EROWS = CAPC + CAPL, NSLOT = NEXP * EROWS, DFF = 1024;
constexpr float ALPHA = 1.41421356237309515f;
constexpr size_t O_Y = 0, O_CKV = (size_t)NT * DM, O_KPE = O_CKV + (size_t)16 * 2 * 256 * 512, O_HG = O_KPE + (size_t)16 * 2 * 256 * 64,
                 O_RG = O_HG + (size_t)16 * 2 * 2 * 4 * 128 * 128, O_END = O_RG + (size_t)16 * 2 * 2 * 512;

typedef unsigned short bf16_t;
typedef float f32x4_t __attribute__((ext_vector_type(4)));
typedef unsigned u32x4_t __attribute__((ext_vector_type(4)));
__device__ __forceinline__ float bf2f(bf16_t b) { return __uint_as_float(((unsigned)b) << 16); }
__device__ __forceinline__ bf16_t f2bf(float f) { unsigned u = __float_as_uint(f); u += 0x7FFFu + ((u >> 16) & 1u); return (bf16_t)(u >> 16); }
__device__ __forceinline__ unsigned cvtpk2(float lo, float hi) { unsigned r; asm volatile("v_cvt_pk_bf16_f32 %0, %1, %2" : "=v"(r) : "v"(lo), "v"(hi)); return r; }
__device__ __forceinline__ float sigmoidf_(float x) { return 1.0f / (1.0f + expf(-x)); }
__device__ __forceinline__ float siluf_(float x) { return x * sigmoidf_(x); }
__device__ __forceinline__ float gelu_tanh_(float x) { const float u = 0.7978845608028654f * (x + 0.044715f * x * x * x); return x * __builtin_amdgcn_rcpf(1.0f + __expf(-2.0f * u)); }

constexpr size_t al256(size_t x) { return (x + 255) / 256 * 256; }
constexpr size_t WS_CTL = 0, CTL_BYTES = 1u << 20, CTL_ZERO = 32768;
constexpr size_t WS_MODS = WS_CTL + CTL_BYTES;
constexpr size_t WS_LB = WS_MODS + al256((size_t)2 * 3 * 6 * DM * 4);
constexpr size_t WS_ROPE = WS_LB + al256((size_t)2 * 2 * 512 * 4);
constexpr size_t WS_PROB = WS_ROPE + al256((size_t)2 * 64 * 16 * 4);
constexpr size_t WS_SLOT = WS_PROB + al256((size_t)NT * 16 * 4);
constexpr size_t WS_RIDX = WS_SLOT + al256((size_t)NT * 16 * 4);
constexpr size_t WS_GATE = WS_RIDX + al256((size_t)NSLOT * 4);
constexpr size_t WS_WIN = WS_GATE + al256((size_t)NSLOT * 4);
constexpr size_t WS_WOUT = WS_WIN + al256((size_t)2 * LDZ * DM * 2);
constexpr size_t WS_WUQ = WS_WOUT + al256((size_t)2 * DM * DM * 2);
constexpr size_t WS_WUKV = WS_WUQ + al256((size_t)2 * 1536 * 512 * 2);
constexpr size_t WS_WGU = WS_WUKV + al256((size_t)2 * 2048 * 512 * 2);
constexpr size_t WS_WD = WS_WGU + al256((size_t)2 * NEXP * 2048 * DM * 2);
constexpr size_t WS_WRG = WS_WD + al256((size_t)2 * NEXP * DM * DFF * 2);
constexpr size_t WS_RGC = WS_WRG + al256((size_t)32 * 128 * 128 * 2);
constexpr size_t WS_RT = WS_RGC + al256((size_t)3 * 2 * 192 * 512 * 4);
constexpr size_t WS_XN = WS_RT + al256((size_t)2 * 16 * DM * 4);
constexpr size_t WS_HM = WS_XN + al256((size_t)NT * DM * 4);
constexpr size_t WS_Z = WS_HM + al256((size_t)NT * DM * 2);
constexpr size_t WS_CQN = WS_Z + al256((size_t)NT * LDZ * 2);
constexpr size_t WS_CKVA = WS_CQN + al256((size_t)NT * 512 * 2);
constexpr size_t WS_KPEA = WS_CKVA + al256((size_t)NKV * 512 * 2);
constexpr size_t WS_QM = WS_KPEA + al256((size_t)NKV * 64 * 2);
constexpr size_t WS_KN = WS_QM + al256((size_t)NT * 1536 * 2);
constexpr size_t WS_VV = WS_KN + al256((size_t)NKV * 1024 * 2);
constexpr size_t WS_OMIX = WS_VV + al256((size_t)NKV * 1024 * 2);
constexpr size_t WS_XCV = WS_OMIX + al256((size_t)NT * DM * 2);
constexpr size_t WS_RGA = WS_XCV + al256((size_t)NT * 512 * 4);
constexpr size_t WS_RGX = WS_RGA + al256((size_t)2 * NT * 512 * 4);
constexpr size_t WS_RGH = WS_RGX + al256((size_t)2 * NT * 512 * 4);
constexpr size_t WS_OHG = WS_RGH + al256((size_t)2 * NT * 512 * 4);
constexpr size_t WS_QS = WS_OHG + al256((size_t)2 * NT * 512 * 4);
constexpr size_t WS_DT = WS_QS + al256((size_t)2 * NT * 512 * 2);
constexpr size_t WS_END = WS_DT + al256((size_t)2 * 192 * 4 * 128 * 4);
constexpr size_t WS_LNS = WS_DT;
constexpr size_t WS_DS = WS_RGH;
constexpr size_t WS_SST = WS_HM;
constexpr size_t WS_X1 = WS_Z;
constexpr size_t WS_HF = WS_HM;
constexpr size_t WS_XS = WS_QM;
constexpr size_t WS_HID = WS_RGA;
static_assert((size_t)NT * DM * 4 <= (size_t)NT * LDZ * 2 && WS_XS + (size_t)NSLOT * DM * 2 <= WS_XCV && (size_t)NSLOT * DFF * 2 <= (size_t)2 * NT * 512 * 4, "overlays");

#define XB_TMO      128
#define XB_XCNT(j)  (256  + 64 * (j))
#define XB_XSUB(j)  (1280 + 64 * (j))
#define XB_XGEN(j)  (2304 + 64 * (j))
#define XB_TOP      3328
#define XB_TOPGEN   3392
#define XCD_BAR_WORDS 3456
#define XB_SPIN_CAP (1u << 24)
#define LAS __attribute__((address_space(3)))
__device__ __forceinline__ unsigned xb_ld(unsigned* p)              { return __hip_atomic_load(p, __ATOMIC_RELAXED, __HIP_MEMORY_SCOPE_AGENT); }
__device__ __forceinline__ unsigned xb_add(unsigned* p, unsigned v) { return __hip_atomic_fetch_add(p, v, __ATOMIC_RELAXED, __HIP_MEMORY_SCOPE_AGENT); }
__device__ __forceinline__ unsigned xb_xcc_id() { return (unsigned)__builtin_amdgcn_s_getreg((3 << 11) | 20) & 0xFu; }
#define XB_SPIN(cond, bar) do { unsigned _sp = 0; while (cond) { __builtin_amdgcn_s_sleep(1); \
    if ((++_sp & 255u) == 0u) { if (xb_ld(&(bar)[XB_TMO])) break; if (_sp > XB_SPIN_CAP) { atomicAdd(&(bar)[XB_TMO], 1u); break; } } } } while (0)
struct XcdBarrier { unsigned* bar; unsigned x; volatile LAS unsigned* st; };
__device__ __forceinline__ XcdBarrier xcd_barrier_post(unsigned* bar, volatile LAS unsigned* st) {
    XcdBarrier b; b.bar = bar; b.x = xb_xcc_id(); b.st = st;
    if (threadIdx.x == 0) (void)xb_add(&bar[XB_XCNT(b.x)], 1u);
    return b;
}
__device__ __forceinline__ void xcd_barrier_complete(unsigned* bar, unsigned x, unsigned& nloc, unsigned& nx) {
    const unsigned G = gridDim.x * gridDim.y * gridDim.z;
    unsigned sum, cnt, mine, sp = 0u;
    for (;;) {
        sum = 0u; cnt = 0u; mine = 0u;
#pragma unroll
        for (unsigned j = 0; j < 16; ++j) { const unsigned c = xb_ld(&bar[XB_XCNT(j)]); sum += c; cnt += (c > 0u) ? 1u : 0u; mine = (j == x) ? c : mine; }
        if (sum == G) break;
        __builtin_amdgcn_s_sleep(1);
        if ((++sp & 255u) == 0u) { if (xb_ld(&bar[XB_TMO])) break; if (sp > XB_SPIN_CAP) { atomicAdd(&bar[XB_TMO], 1u); break; } }
    }
    nloc = mine > 0u ? mine : 1u; nx = cnt > 0u ? cnt : 1u;
}
__device__ __forceinline__ void xcd_barrier(const XcdBarrier& b) {
    asm volatile("s_waitcnt vmcnt(0)" ::: "memory");
    __syncthreads();
    if (threadIdx.x == 0) {
        unsigned* bar = b.bar;
        __builtin_amdgcn_s_waitcnt(0);
        unsigned nloc = b.st[0], nx = b.st[1];
        if (nloc == 0u) { xcd_barrier_complete(bar, b.x, nloc, nx); b.st[0] = nloc; b.st[1] = nx; }
        const unsigned old = xb_add(&bar[XB_XSUB(b.x)], 1u);
        const unsigned gen = old / nloc;
        if (old + 1u == (gen + 1u) * nloc) {
            __builtin_amdgcn_fence(__ATOMIC_RELEASE, "agent");
            asm volatile("s_waitcnt vmcnt(0)" ::: "memory");
            const unsigned og = xb_add(&bar[XB_TOP], 1u);
            const unsigned tg = og / nx;
            if (og + 1u == (tg + 1u) * nx) xb_add(&bar[XB_TOPGEN], 1u);
            else XB_SPIN(xb_ld(&bar[XB_TOPGEN]) == tg, bar);
            __builtin_amdgcn_fence(__ATOMIC_ACQUIRE, "agent");
            xb_add(&bar[XB_XGEN(b.x)], 1u);
            asm volatile("s_waitcnt vmcnt(0)" ::: "memory");
        } else {
            XB_SPIN(xb_ld(&bar[XB_XGEN(b.x)]) == gen, bar);
            __builtin_amdgcn_fence(__ATOMIC_ACQUIRE, "agent");
            asm volatile("s_waitcnt vmcnt(0)" ::: "memory");
        }
    }
    __syncthreads();
}

enum { I_XP = 0, I_XS, I_CCKV, I_CKPE, I_SHG, I_SRG, I_C, I_CCTX, I_WIN, I_WOUT, I_LBL, I_HGN, I_CONVW, I_CONVB, I_WR, I_BR, I_WI, I_BI, I_LAM,
       I_QNG, I_KVNG, I_WUQ, I_WUK, I_WUV, I_ADAW, I_ADAB, I_LN1G, I_LN1B, I_LN2G, I_LN2B, I_ROUT, I_WG, I_WU, I_WD, N_IN };
struct Args { const float* in[N_IN]; float* out; unsigned char* ws; int ph_lo, ph_hi; };
constexpr int NTHR = 512;
constexpr int LDS_BYTES = 163840;
constexpr int LDS_MISC = 163840 - 256;

struct F {
    const float* const* in; float* out; unsigned char* ws; unsigned char* lds; int tid, bid, nb;
    __device__ __forceinline__ float* modp(int l, int g) const { return (float*)(ws + WS_MODS) + ((size_t)l * 3 + g) * (6 * DM); }
};
#define GAS __attribute__((address_space(1)))
__device__ __forceinline__ F launder(F f) { asm volatile("" : "+v"(f.tid)); asm volatile("" : "+s"(f.bid), "+s"(f.nb)); { GAS unsigned char* gw = (GAS unsigned char*)f.ws; GAS float* go = (GAS float*)f.out; asm volatile("" : "+s"(gw), "+s"(go)); f.ws = (unsigned char*)gw; f.out = (float*)go; }
    return f; }
__device__ __forceinline__ int xcd_deal(const F& f, int k, int total) {
    if ((f.nb & 7) || (total & 7)) { const int u = f.bid + k * f.nb; return u < total ? u : -1; }
    const int per = total >> 3, W = f.nb >> 3, j = (f.bid >> 3) + k * W; return j < per ? (f.bid & 7) * per + j : -1;
}
__device__ __forceinline__ int tok_group(int t) { return t < NCTX ? 0 : 1 + ((t - NCTX) >> 12); }
__device__ __forceinline__ int seq_base(int s) { return s < 16 ? s * SEQC : NCTX + (s - 16) * SEQL; }
__device__ __forceinline__ int seq_len(int s) { return s < 16 ? SEQC : SEQL; }
__device__ __forceinline__ int kv_base(int s) { return s < 16 ? s * SEQC : NCTX + (s - 16) * (SEQL + PAST); }
__device__ __forceinline__ int kv_len(int s) { return s < 16 ? SEQC : SEQL + PAST; }
__device__ __forceinline__ int kv_row_of_tok(int t) { return t < NCTX ? t : NCTX + ((t - NCTX) >> 12) * (SEQL + PAST) + ((t - NCTX) & 4095); }

__device__ __forceinline__ float block_sum(float v, float* red, int tid) {
    for (int o = 32; o >= 1; o >>= 1) v += __shfl_xor(v, o);
    __syncthreads();
    if ((tid & 63) == 0) red[tid >> 6] = v;
    __syncthreads();
    float s = 0.f;
#pragma unroll
    for (int i = 0; i < 8; ++i) s += red[i];
    return s;
}


namespace pg8 {
#define PG8_LAS __attribute__((address_space(3)))
typedef short bf16x8 __attribute__((ext_vector_type(8)));
typedef float f32x4 __attribute__((ext_vector_type(4)));
typedef unsigned u32x4 __attribute__((ext_vector_type(4)));
constexpr int BM = 256, BK = 64, HALF = 128, HTB = HALF * BK * 2  , STAGE_BYTES = 8 * HTB, NXCD = 8, WGM = 8;

__host__ __device__ __forceinline__ int lds_byte(int r, int c) { const int st = (r >> 4) * 2 + (c >> 5), rr = r & 15, cc = c & 31, ob = rr * 64 + cc * 2; return st * 1024 + (ob ^ (((ob >> 9) & 1) << 5)); }
__host__ __device__ __forceinline__ void stage_rc(int b, int& R, int& C) { const int st = b / 1024, sb = b % 1024, swz = sb ^ (((sb >> 9) & 1) << 5); R = (st >> 1) * 16 + swz / 64; C = (st & 1) * 32 + (swz % 64) / 2; }
__host__ __device__ __forceinline__ int perm32(int rho) { const int n = rho >> 4, i = rho & 15; return 8 * (i >> 2) + 4 * n + (i & 3); }

struct Unit { int pm, pn; };
struct Gemm { const bf16_t* A; const bf16_t* Bt; int M, N, K; int mper; size_t bstride; };

struct StaticOrder {
    int nM, nN, nwg, G, c;
    __host__ __device__ void init(int M, int N, int G_, int c_) { nM = M / BM; nN = N / BM; nwg = nM * nN; G = G_; c = c_; }
    __host__ __device__ bool next(int i, Unit& u) const {
        const long L = (long)i * G + c; if (L >= nwg) return false;
        int wgid = (int)L; { const int q = nwg / NXCD, r = nwg % NXCD, xcd = wgid % NXCD, off = wgid / NXCD; wgid = (xcd < r ? xcd * (q + 1) : r * (q + 1) + (xcd - r) * q) + off; }
        const int nig = WGM * nN, gid = wgid / nig, fm = gid * WGM, gsz = (nM - fm) < WGM ? (nM - fm) : WGM;
        u.pm = fm + ((wgid % nig) % gsz); u.pn = (wgid % nig) / gsz; return true;
    }
    __device__ __forceinline__ void a_ready(const Unit&) const {}
    __device__ __forceinline__ void done(const Unit&) const {}
};
__device__ __forceinline__ unsigned cvt_pk_bf16(float lo, float hi) { unsigned r; asm volatile("v_cvt_pk_bf16_f32 %0, %1, %2" : "=v"(r) : "v"(lo), "v"(hi)); return r; }
template <class Epi, class Sched, bool STAMP = false, bool GATHER = false>
__device__ __forceinline__ void gemm_phase(PG8_LAS unsigned char* lds, const Gemm g, const Sched& S, const Epi& E, unsigned long long* stamps, const int* ridx = nullptr) {
    int tid_ = threadIdx.x; asm volatile("" : "+v"(tid_));
    const int tid = tid_, wid = __builtin_amdgcn_readfirstlane(tid >> 6), lane = tid & 63, wr = wid >> 2, wc = wid & 3, fr = lane & 15, fq = lane >> 4;
    const int K = g.K, nt = K / BK;
    int ts_lo = 0, ts_hi = 0, nts = 0; const unsigned long long rt_entry = STAMP ? (unsigned long long)wall_clock64() : 0ull;
#define PG8_STAMP() do { if (STAMP && wid == 0 && nts < 64) { const unsigned long long _c = (unsigned long long)clock64(); \
        ts_lo = (lane == nts) ? (int)(unsigned)_c : ts_lo; ts_hi = (lane == nts) ? (int)(unsigned)(_c >> 32) : ts_hi; ++nts; } } while (0)
    PG8_STAMP();
    unsigned voffA[2], voffB[2];
#pragma unroll
    for (int i = 0; i < 2; ++i) { int R, C; stage_rc(tid * 16 + i * 8192, R, C); const int Rb = Epi::PERM ? ((R & ~31) + perm32(R & 31)) : R;
        voffA[i] = (unsigned)(R * K + C) * 2u; voffB[i] = (unsigned)(Rb * K + C) * 2u; }
    const size_t kstep = (size_t)(BK * 2);
    const size_t hstep = (size_t)HALF * K * 2;
    const size_t hstepA = GATHER ? 0 : hstep;
    unsigned vgC[2][2], vgN[2][2];
#define PG8_VG(vg, pm_) do { _Pragma("unroll") for (int _h = 0; _h < 2; ++_h) _Pragma("unroll") for (int _i = 0; _i < 2; ++_i) { int R_, C_; stage_rc(tid * 16 + _i * 8192, R_, C_); \
        vg[_h][_i] = ((unsigned)ridx[(pm_) * BM + _h * HALF + R_] * (unsigned)K + (unsigned)C_) * 2u; } } while (0)
#define PG8_STAGEA(bufoff, gbase, h_, nx_) do { if (GATHER) { unsigned vo_[2]; vo_[0] = (nx_) ? vgN[h_][0] : vgC[h_][0]; vo_[1] = (nx_) ? vgN[h_][1] : vgC[h_][1]; PG8_STAGE(bufoff, gbase, vo_); } else PG8_STAGE(bufoff, (gbase) + (h_) * hstepA, voffA); } while (0)
    const size_t tstep = 2 * hstep;
    const unsigned ldsw = (unsigned)wid * 1024u;
    const int aoff = lds_byte(wr * 64 + fr, fq * 8), boff = lds_byte(wc * 32 + fr, fq * 8);
#define PG8_SA(b, h) (((b) * 2 + (h)) * HTB)
#define PG8_SB(b, h) ((4 + (b) * 2 + (h)) * HTB)
#define PG8_STAGE(bufoff, gbase, voff) do { _Pragma("unroll") for (int _i = 0; _i < 2; ++_i) \
        __builtin_amdgcn_global_load_lds((const unsigned*)((const char*)(gbase) + (voff)[_i]), (PG8_LAS unsigned*)(lds + (bufoff) + ldsw + _i * 8192), 16, 0, 0); } while (0)
#define PG8_LDA(dst, b, h) do { _Pragma("unroll") for (int m = 0; m < 4; ++m) _Pragma("unroll") for (int k = 0; k < 2; ++k) dst[m][k] = *(const PG8_LAS bf16x8*)(lds + PG8_SA(b, h) + aoff + m * 2048 + k * 1024); } while (0)
#define PG8_LDB(dst, b, h) do { _Pragma("unroll") for (int n = 0; n < 2; ++n) _Pragma("unroll") for (int k = 0; k < 2; ++k) dst[n][k] = *(const PG8_LAS bf16x8*)(lds + PG8_SB(b, h) + boff + n * 2048 + k * 1024); } while (0)
#define PG8_MMA(ai, bj, At, Bt) do { __builtin_amdgcn_s_setprio(1); _Pragma("unroll") for (int m = 0; m < 4; ++m) _Pragma("unroll") for (int n = 0; n < 2; ++n) _Pragma("unroll") for (int k = 0; k < 2; ++k) \
        acc[ai][bj][m][n] = __builtin_amdgcn_mfma_f32_16x16x32_bf16(Bt[n][k], At[m][k], acc[ai][bj][m][n], 0, 0, 0); __builtin_amdgcn_s_setprio(0); } while (0)
#define PG8_WAIT_V(n) asm volatile("s_waitcnt vmcnt(" #n ")" ::: "memory")
#define PG8_WAIT_L(n) asm volatile("s_waitcnt lgkmcnt(" #n ")" ::: "memory")
#define PG8_BAR __builtin_amdgcn_s_barrier()
#define PG8_SCHED __builtin_amdgcn_sched_barrier(0)
    Unit cur, nxt; int ui = 0;
    if (!S.next(0, cur)) return;
    f32x4 acc[2][2][4][2];
#pragma unroll
    for (int a = 0; a < 2; ++a)
#pragma unroll
        for (int b = 0; b < 2; ++b)
#pragma unroll
            for (int m = 0; m < 4; ++m)
#pragma unroll
                for (int n = 0; n < 2; ++n) acc[a][b][m][n] = (f32x4){0.f, 0.f, 0.f, 0.f};
    bf16x8 At[4][2], B0[2][2], B1[2][2];
    const char* cA = (const char*)g.A + (GATHER ? (size_t)0 : (size_t)cur.pm * tstep); if (GATHER) PG8_VG(vgC, cur.pm);
    const char* cB = (const char*)(g.Bt + (size_t)(cur.pm / g.mper) * g.bstride) + (size_t)cur.pn * tstep;
    S.a_ready(cur);
    PG8_STAGE(PG8_SB(0, 0), cB, voffB); PG8_STAGEA(PG8_SA(0, 0), cA, 0, false); PG8_STAGE(PG8_SB(0, 1), cB + hstep, voffB); PG8_STAGEA(PG8_SA(0, 1), cA, 1, false);
    if (wr == 1) PG8_BAR;
    PG8_WAIT_V(4); PG8_BAR;
    PG8_STAGE(PG8_SB(1, 0), cB + kstep, voffB); PG8_STAGEA(PG8_SA(1, 0), cA + kstep, 0, false); PG8_STAGE(PG8_SB(1, 1), cB + hstep + kstep, voffB);
    PG8_WAIT_V(6); PG8_BAR;
    PG8_STAMP();
    for (;;) {
        const bool has_next = S.next(ui + 1, nxt);
        const char* nA = (has_next && !GATHER) ? (const char*)g.A + (size_t)nxt.pm * tstep : cA; if (GATHER && has_next) PG8_VG(vgN, nxt.pm);
        const char* nB = has_next ? (const char*)(g.Bt + (size_t)(nxt.pm / g.mper) * g.bstride) + (size_t)nxt.pn * tstep : cB;
        for (int t = 0; t < nt; t += 2) {
            const bool last = (t == nt - 2);
            const char* a1 = cA + (size_t)(t + 1) * kstep;
            const char* a2 = last ? nA : cA + (size_t)(t + 2) * kstep; const char* b2 = last ? nB : cB + (size_t)(t + 2) * kstep;
            const char* a3 = a2 + kstep; const char* b3 = b2 + kstep;
            if (last && has_next) S.a_ready(nxt);
            PG8_LDB(B0, 0, 0); PG8_SCHED; PG8_LDA(At, 0, 0); PG8_STAGEA(PG8_SA(1, 1), a1, 1, false);
            PG8_WAIT_L(8); PG8_BAR; PG8_WAIT_L(0); PG8_MMA(0, 0, At, B0); PG8_BAR; PG8_SCHED;
            PG8_LDB(B1, 0, 1); PG8_STAGE(PG8_SB(0, 0), b2, voffB);
            PG8_BAR; PG8_WAIT_L(0); PG8_MMA(0, 1, At, B1); PG8_BAR;
            PG8_LDA(At, 0, 1); PG8_STAGEA(PG8_SA(0, 0), a2, 0, last && has_next);
            PG8_BAR; PG8_WAIT_L(0); PG8_MMA(1, 0, At, B0); PG8_BAR; PG8_SCHED;
            PG8_STAGE(PG8_SB(0, 1), b2 + hstep, voffB);
            PG8_WAIT_V(6); PG8_BAR; PG8_MMA(1, 1, At, B1); PG8_BAR;
            PG8_LDB(B0, 1, 0); PG8_SCHED; PG8_LDA(At, 1, 0); PG8_STAGEA(PG8_SA(0, 1), a2, 1, last && has_next);
            PG8_WAIT_L(8); PG8_BAR; PG8_WAIT_L(0); PG8_MMA(0, 0, At, B0); PG8_BAR; PG8_SCHED;
            PG8_LDB(B1, 1, 1); PG8_STAGE(PG8_SB(1, 0), b3, voffB);
            PG8_BAR; PG8_WAIT_L(0); PG8_MMA(0, 1, At, B1); PG8_BAR;
            PG8_LDA(At, 1, 1); PG8_STAGEA(PG8_SA(1, 0), a3, 0, last && has_next);
            PG8_BAR; PG8_WAIT_L(0); PG8_MMA(1, 0, At, B0); PG8_BAR; PG8_SCHED;
            PG8_STAGE(PG8_SB(1, 1), b3 + hstep, voffB);
            PG8_WAIT_V(6); PG8_BAR; PG8_MMA(1, 1, At, B1); PG8_BAR;
        }
        PG8_STAMP();
        if constexpr (!Epi::AFTER_DRAIN) { E(acc, cur, wr, wc, fr, fq); S.done(cur); }
        PG8_STAMP();
        if (!has_next) break;
#pragma unroll
        for (int a = 0; a < 2; ++a)
#pragma unroll
            for (int b = 0; b < 2; ++b)
#pragma unroll
                for (int m = 0; m < 4; ++m)
#pragma unroll
                    for (int n = 0; n < 2; ++n) acc[a][b][m][n] = (f32x4){0.f, 0.f, 0.f, 0.f};
        cur = nxt; cA = nA; cB = nB; ++ui;
        if (GATHER) { _Pragma("unroll") for (int _h = 0; _h < 2; ++_h) _Pragma("unroll") for (int _i = 0; _i < 2; ++_i) vgC[_h][_i] = vgN[_h][_i]; }
    }
    PG8_WAIT_V(0);
    if (wr == 0) PG8_BAR;
    PG8_BAR;
    if constexpr (Epi::AFTER_DRAIN) { E.fused(acc, cur, wr, wc, fr, fq, lds, wid, lane); S.done(cur); }
    PG8_STAMP();
    if (STAMP && wid == 0) { stamps[lane] = lane < nts ? (((unsigned long long)(unsigned)ts_hi << 32) | (unsigned)ts_lo) : 0ull;
        if (lane == 62) stamps[62] = rt_entry; if (lane == 63) stamps[63] = (unsigned long long)wall_clock64(); }
#undef PG8_STAMP
#undef PG8_SA
#undef PG8_SB
#undef PG8_STAGE
#undef PG8_STAGEA
#undef PG8_VG
#undef PG8_LDA
#undef PG8_LDB
#undef PG8_MMA
#undef PG8_WAIT_V
#undef PG8_WAIT_L
#undef PG8_BAR
#undef PG8_SCHED
}
}

namespace pg8 {
struct EpiB16 {
    static constexpr bool PERM = true, AFTER_DRAIN = false;
    bf16_t* O; int ldc; int split_cols; size_t split_stride;
    __device__ __forceinline__ void operator()(const f32x4 (&acc)[2][2][4][2], const Unit& u, int wr, int wc, int fr_, int fq_) const {
        int fr = fr_, fq = fq_; asm volatile("s_nop 15\n\ts_nop 15" : "+v"(fr), "+v"(fq));
        const int row0 = u.pm * BM + wr * 64 + fr; int colt = u.pn * BM; bf16_t* base = O;
        if (split_cols) { const int t = colt / split_cols; base += (size_t)t * split_stride; colt -= t * split_cols; }
        const int col0 = colt + wc * 32 + 8 * fq;
#pragma unroll
        for (int ai = 0; ai < 2; ++ai)
#pragma unroll
            for (int m = 0; m < 4; ++m) { bf16_t* rowp = base + (size_t)(row0 + ai * HALF + m * 16) * ldc + col0;
#pragma unroll
                for (int bj = 0; bj < 2; ++bj) { const f32x4 v0 = acc[ai][bj][m][0], v1 = acc[ai][bj][m][1];
                    u32x4 w; w.x = cvt_pk_bf16(v0[0], v0[1]); w.y = cvt_pk_bf16(v0[2], v0[3]); w.z = cvt_pk_bf16(v1[0], v1[1]); w.w = cvt_pk_bf16(v1[2], v1[3]);
                    *(u32x4*)(rowp + bj * HALF) = w; } }
    }
};
struct EpiOutProj {
    static constexpr bool PERM = false, AFTER_DRAIN = false;
    const float* xbase; long long dlat; const float* mods; bf16_t* pre; const bf16_t* xb16;
    __device__ __forceinline__ void operator()(const f32x4 (&acc)[2][2][4][2], const Unit& u, int wr, int wc, int fr_, int fq_) const {
        int fr = fr_, fq = fq_; asm volatile("" : "+v"(fr), "+v"(fq));
        const int trow = u.pm * BM; const int grp = trow < NCTX ? 0 : 1 + ((trow - NCTX) >> 12);
        const float* g1 = mods + (size_t)grp * 6 * DM + 2 * DM;
        const float* xb = xbase + (trow < NCTX ? 0ll : dlat) + (size_t)trow * DM;
        const int r0 = wr * 64 + fr, col0 = u.pn * BM + wc * 32 + 4 * fq;
        typedef unsigned u32x2 __attribute__((ext_vector_type(2)));
        if (xb16 == nullptr) {
#pragma unroll
        for (int ai = 0; ai < 2; ++ai)
#pragma unroll
            for (int m = 0; m < 4; ++m) { const int r = r0 + ai * HALF + m * 16; const float* xr = xb + (size_t)r * DM + col0; bf16_t* pr = pre + (size_t)(trow + r) * DM + col0;
#pragma unroll
                for (int bj = 0; bj < 2; ++bj)
#pragma unroll
                    for (int n = 0; n < 2; ++n) { const f32x4 xv = *(const f32x4*)(xr + bj * HALF + n * 16); const f32x4 gv = *(const f32x4*)(g1 + col0 + bj * HALF + n * 16);
                        const f32x4 y = xv * ALPHA + gv * acc[ai][bj][m][n]; u32x2 w; w.x = cvt_pk_bf16(y[0], y[1]); w.y = cvt_pk_bf16(y[2], y[3]);
                        *(u32x2*)(pr + bj * HALF + n * 16) = w; }
                asm volatile("" ::: "memory"); }
        } else {
#pragma unroll
        for (int ai = 0; ai < 2; ++ai)
#pragma unroll
            for (int m = 0; m < 4; ++m) { const int r = r0 + ai * HALF + m * 16; const bf16_t* xr = xb16 + (size_t)(trow + r) * DM + col0; bf16_t* pr = pre + (size_t)(trow + r) * DM + col0;
#pragma unroll
                for (int bj = 0; bj < 2; ++bj)
#pragma unroll
                    for (int n = 0; n < 2; ++n) { const u32x2 xw = *(const u32x2*)(xr + bj * HALF + n * 16); const f32x4 gv = *(const f32x4*)(g1 + col0 + bj * HALF + n * 16);
                        const f32x4 xv = {__uint_as_float(xw.x << 16), __uint_as_float(xw.x & 0xffff0000u), __uint_as_float(xw.y << 16), __uint_as_float(xw.y & 0xffff0000u)};
                        const f32x4 y = xv * ALPHA + gv * acc[ai][bj][m][n]; u32x2 w; w.x = cvt_pk_bf16(y[0], y[1]); w.y = cvt_pk_bf16(y[2], y[3]);
                        *(u32x2*)(pr + bj * HALF + n * 16) = w; }
                asm volatile("" ::: "memory"); }
        }
    }
};
struct EpiMoe1 {
    static constexpr bool PERM = true, AFTER_DRAIN = false;
    bf16_t* hid;
    __device__ __forceinline__ void operator()(const f32x4 (&acc)[2][2][4][2], const Unit& u, int wr, int wc, int fr_, int fq_) const {
        int fr = fr_, fq = fq_; asm volatile("" : "+v"(fr), "+v"(fq));
        const int row0 = u.pm * BM + wr * 64 + fr, hc0 = u.pn * (BM / 2) + wc * 16 + 4 * fq;
#pragma unroll
        for (int ai = 0; ai < 2; ++ai)
#pragma unroll
            for (int m = 0; m < 4; ++m) { bf16_t* rowp = hid + (size_t)(row0 + ai * HALF + m * 16) * DFF + hc0;
#pragma unroll
                for (int bj = 0; bj < 2; ++bj) { const f32x4 g = acc[ai][bj][m][0], uu = acc[ai][bj][m][1]; float h[4];
#pragma unroll
                    for (int j = 0; j < 4; ++j) h[j] = g[j] * __builtin_amdgcn_rcpf(1.0f + __expf(-g[j])) * uu[j];
                    typedef unsigned u32x2 __attribute__((ext_vector_type(2)));
                    u32x2 w; w.x = cvt_pk_bf16(h[0], h[1]); w.y = cvt_pk_bf16(h[2], h[3]);
                    *(u32x2*)(rowp + bj * (HALF / 2)) = w; } }
    }
};
struct EpiMoe2 {
    static constexpr bool PERM = true, AFTER_DRAIN = false;
    bf16_t* ys; const float* gate;
    __device__ __forceinline__ void operator()(const f32x4 (&acc)[2][2][4][2], const Unit& u, int wr, int wc, int fr_, int fq_) const {
        int fr = fr_, fq = fq_; asm volatile("" : "+v"(fr), "+v"(fq));
        const int row0 = u.pm * BM + wr * 64 + fr, col0 = u.pn * BM + wc * 32 + 8 * fq;
#pragma unroll
        for (int ai = 0; ai < 2; ++ai)
#pragma unroll
            for (int m = 0; m < 4; ++m) { const int r = row0 + ai * HALF + m * 16; const float gt = gate[r]; bf16_t* rowp = ys + (size_t)r * DM + col0;
#pragma unroll
                for (int bj = 0; bj < 2; ++bj) { const f32x4 v0 = acc[ai][bj][m][0] * gt, v1 = acc[ai][bj][m][1] * gt;
                    u32x4 w; w.x = cvt_pk_bf16(v0[0], v0[1]); w.y = cvt_pk_bf16(v0[2], v0[3]); w.z = cvt_pk_bf16(v1[0], v1[1]); w.w = cvt_pk_bf16(v1[2], v1[3]);
                    *(u32x4*)(rowp + bj * HALF) = w; } }
    }
};
}

#define LDS_BARRIER() do { asm volatile("s_waitcnt lgkmcnt(0)" ::: "memory"); __builtin_amdgcn_s_barrier(); asm volatile("" ::: "memory"); } while (0)
struct WTile { const float* a; long long dba; bf16_t* dst; int mode, ld, nmax, n0, k0, K; };
__device__ __forceinline__ WTile wtile_decode(const F& f, int t) {
    constexpr int T_IN = 2 * 38 * 16, T_OUT = 2 * 16 * 16, T_UQ = 2 * 12 * 4, T_UKV = 2 * 16 * 4, T_GU = 2 * 16 * 16 * 16;
    WTile w; int u = t;
    if (u < T_IN) { const int l = u / (38 * 16), r = u % (38 * 16); w.a = f.in[I_WIN] + (size_t)l * DM * INC; w.dba = 0; w.dst = (bf16_t*)(f.ws + WS_WIN) + (size_t)l * LDZ * DM; w.mode = 0; w.ld = INC; w.nmax = INC; w.n0 = (r / 16) * 128; w.k0 = (r % 16) * 128; w.K = DM; return w; }
    u -= T_IN;
    if (u < T_OUT) { const int l = u / (16 * 16), r = u % (16 * 16); w.a = f.in[I_WOUT] + (size_t)l * DM * DM; w.dba = 0; w.dst = (bf16_t*)(f.ws + WS_WOUT) + (size_t)l * DM * DM; w.mode = 0; w.ld = DM; w.nmax = DM; w.n0 = (r / 16) * 128; w.k0 = (r % 16) * 128; w.K = DM; return w; }
    u -= T_OUT;
    if (u < T_UQ) { const int l = u / (12 * 4), r = u % (12 * 4); w.a = f.in[I_WUQ] + (size_t)l * 512 * 1536; w.dba = 0; w.dst = (bf16_t*)(f.ws + WS_WUQ) + (size_t)l * 1536 * 512; w.mode = 0; w.ld = 1536; w.nmax = 1536; w.n0 = (r / 4) * 128; w.k0 = (r % 4) * 128; w.K = 512; return w; }
    u -= T_UQ;
    if (u < T_UKV) { const int l = u / (16 * 4), r = u % (16 * 4); w.a = f.in[I_WUK] + (size_t)l * 512 * 1024; w.dba = (f.in[I_WUV] + (size_t)l * 512 * 1024) - w.a; w.dst = (bf16_t*)(f.ws + WS_WUKV) + (size_t)l * 2048 * 512; w.mode = 1; w.ld = 1024; w.nmax = 2048; w.n0 = (r / 4) * 128; w.k0 = (r % 4) * 128; w.K = 512; return w; }
    u -= T_UKV;
    if (u < T_GU) { const int le = u / (16 * 16), r = u % (16 * 16); w.a = f.in[I_WG] + (size_t)le * DM * DFF; w.dba = (f.in[I_WU] + (size_t)le * DM * DFF) - w.a; w.dst = (bf16_t*)(f.ws + WS_WGU) + (size_t)le * 2048 * DM; w.mode = 2; w.ld = DFF; w.nmax = 2048; w.n0 = (r / 16) * 128; w.k0 = (r % 16) * 128; w.K = DM; return w; }
    u -= T_GU;
    { const int le = u / (16 * 8), r = u % (16 * 8); w.a = f.in[I_WD] + (size_t)le * DFF * DM; w.dba = 0; w.dst = (bf16_t*)(f.ws + WS_WD) + (size_t)le * DM * DFF; w.mode = 0; w.ld = DM; w.nmax = DM; w.n0 = (r / 8) * 128; w.k0 = (r % 8) * 128; w.K = DFF; return w; }
}
__device__ __forceinline__ void wtile_load(const WTile& w, int tid, f32x4_t (&v)[8]) {
    const int n = w.n0 + (tid & 31) * 4, k = w.k0 + (tid >> 5); const float* p;
    if (w.mode == 0) p = w.a + (size_t)k * w.ld + (n < w.nmax ? n : w.n0);
    else if (w.mode == 1) p = w.a + (n < 1024 ? 0ll : w.dba - 1024) + (size_t)k * 1024 + n;
    else { const int j = 4 * (n >> 3); p = w.a + ((n & 4) ? w.dba : 0ll) + (size_t)k * w.ld + j; }
    const size_t st = (size_t)16 * (w.mode == 1 ? 1024 : w.ld);
#pragma unroll
    for (int i = 0; i < 8; ++i) v[i] = __builtin_nontemporal_load((const f32x4_t*)(p + i * st));
    if (w.mode == 0 && w.n0 + 128 > w.nmax) {
        const bool ok = n < w.nmax;
#pragma unroll
        for (int i = 0; i < 8; ++i) v[i] = ok ? v[i] : (f32x4_t){0.f, 0.f, 0.f, 0.f}; }
}
constexpr int WC_IN = 112 * 11, WC_OUT = 128 * 11;
__device__ __forceinline__ int wset_tile(int set, int k) {
    if (set == 0) { if (k < 608) return k; k -= 608; if (k < 256) return 1216 + k; k -= 256; if (k < 48) return 1728 + k; k -= 48; return 1824 + k; }
    if (set == 1) { if (k < 608) return 608 + k; k -= 608; if (k < 256) return 1472 + k; k -= 256; if (k < 48) return 1776 + k; k -= 48; if (k < 64) return 1888 + k; k -= 64; if (k < 4096) return 1952 + k; k -= 4096; return 10144 + k; }
    if (k < 4096) return 6048 + k; k -= 4096; return 12192 + k;
}
__device__ __forceinline__ void ph_wconvert(const F& f, int set, int kbeg, int kend, int first, int stride) {
    const int T_ALL = kend; first += kbeg;
    float* T = (float*)f.lds;
    const int tid = f.tid;
    f32x4_t v[8];
    int t = first;
    if (t >= T_ALL) return;
    WTile w = wtile_decode(f, wset_tile(set, t));
    wtile_load(w, tid, v);
    for (;;) {
        LDS_BARRIER();
        { const int n4 = (tid & 31) * 4, kq = tid >> 5;
#pragma unroll
          for (int i = 0; i < 8; ++i) *(f32x4_t*)&T[(kq + 16 * i) * 132 + (n4 ^ (((kq >> 3) + 2 * i) << 2))] = v[i]; }
        const int tn = t + stride; const bool more = tn < T_ALL;
        WTile wn = w; if (more) { wn = wtile_decode(f, wset_tile(set, tn)); wtile_load(wn, tid, v); }
        LDS_BARRIER();
        { const int kc = tid & 15, nq = tid >> 4;
          bf16_t* dp = w.dst + (size_t)(w.n0 + nq) * w.K + w.k0 + kc * 8; const size_t dst_st = (size_t)32 * w.K; const float* Tr = T + kc * 8 * 132;
#pragma unroll
          for (int i = 0; i < 4; ++i) { const int col = (nq + 32 * i) ^ (kc << 2);
            float x[8];
#pragma unroll
            for (int j = 0; j < 8; ++j) x[j] = Tr[j * 132 + col];
            u32x4_t o; o.x = pg8::cvt_pk_bf16(x[0], x[1]); o.y = pg8::cvt_pk_bf16(x[2], x[3]); o.z = pg8::cvt_pk_bf16(x[4], x[5]); o.w = pg8::cvt_pk_bf16(x[6], x[7]);
            *(u32x4_t*)(dp + i * dst_st) = o; } }
        if (!more) break;
        t = tn; w = wn;
    }
    __syncthreads();
}

__device__ __forceinline__ void ph_prologue(const F& fin) {
    const F f = launder(fin);
    float* sv = (float*)f.lds;
    float* red = sv + 3 * DM;
    for (int i = f.tid; i < 3 * DM; i += NTHR) { const int g = i / DM, d = i % DM; const float c = g == 0 ? f.in[I_CCTX][d] : f.in[I_C][(g - 1) * DM + d]; sv[i] = siluf_(c); }
    __syncthreads();
    for (int u = f.bid; u < 256; u += f.nb) {
        const int l = u >> 7, cg = u & 127, dl = f.tid / 24, c4 = f.tid % 24;
        f32x4_t a0 = {0.f, 0.f, 0.f, 0.f}, a1 = a0, a2 = a0;
        if (dl < 21) {
            const float* W = f.in[I_ADAW] + (size_t)l * DM * 6 * DM + cg * 96 + c4 * 4;
#pragma unroll 7
            for (int d = dl; d < DM; d += 21) { const f32x4_t w = *(const f32x4_t*)(W + (size_t)d * 6 * DM); a0 += w * sv[d]; a1 += w * sv[DM + d]; a2 += w * sv[2 * DM + d]; }
            *(f32x4_t*)(red + (dl * 3 + 0) * 96 + c4 * 4) = a0; *(f32x4_t*)(red + (dl * 3 + 1) * 96 + c4 * 4) = a1; *(f32x4_t*)(red + (dl * 3 + 2) * 96 + c4 * 4) = a2;
        }
        __syncthreads();
        if (f.tid < 288) { const int g = f.tid / 96, c = f.tid % 96; float sum = 0.f;
            for (int k = 0; k < 21; ++k) sum += red[(k * 3 + g) * 96 + c];
            f.modp(l, g)[cg * 96 + c] = sum + f.in[I_ADAB][(size_t)l * 6 * DM + cg * 96 + c]; }
        __syncthreads();
    }
    float* lb = (float*)(f.ws + WS_LB);
    for (int i = f.bid * NTHR + f.tid; i < 2 * 512; i += f.nb * NTHR) {
        const float x0 = f.in[I_LBL][i], x1 = f.in[I_LBL][2 * 512 + i];
        lb[i] = 0.f; lb[2 * 512 + i] = 1.0f / (1.0f + expf(x0 - x1));
    }
    float* rc = (float*)(f.ws + WS_ROPE); float* rs = rc + 64 * 16;
    for (int i = f.bid * NTHR + f.tid; i < 64 * 16; i += f.nb * NTHR) {
        const int pos = i >> 4, j = i & 15; const float inv = powf(10000.0f, -(float)(2 * j) / 32.0f); const float a = (float)pos * inv;
        rc[i] = cosf(a); rs[i] = sinf(a);
    }
    __syncthreads();
}

__device__ __forceinline__ const float* xrow(const F& f, int l, int t) {
    if (l == 0) return t < NCTX ? f.in[I_XP] + (size_t)t * DM : f.in[I_XS] + (size_t)(t - NCTX) * DM;
    return (const float*)(f.ws + WS_XN) + (size_t)t * DM;
}
__device__ __forceinline__ void ph_mod(const F& fin, int l) {
    const F f = launder(fin);
    bf16_t* hm = (bf16_t*)(f.ws + WS_HM);
#pragma unroll 4
    for (int idx = f.bid * NTHR + f.tid; idx < NT * (DM / 8); idx += f.nb * NTHR) {
        const int t = idx >> 8, c = (idx & 255) * 8; const float* x = xrow(f, l, t) + c; const float* m = f.modp(l, tok_group(t));
        const f32x4_t x0 = *(const f32x4_t*)x, x1 = *(const f32x4_t*)(x + 4), s0 = *(const f32x4_t*)(m + DM + c), s1 = *(const f32x4_t*)(m + DM + c + 4), h0 = *(const f32x4_t*)(m + c), h1 = *(const f32x4_t*)(m + c + 4);
        const f32x4_t y0 = x0 * (s0 + 1.0f) + h0, y1 = x1 * (s1 + 1.0f) + h1;
        u32x4_t w = {cvtpk2(y0[0], y0[1]), cvtpk2(y0[2], y0[3]), cvtpk2(y1[0], y1[1]), cvtpk2(y1[2], y1[3])};
        *(u32x4_t*)(hm + (size_t)t * DM + c) = w;
    }
}
__device__ __forceinline__ void ph_prep(const F& fin, int l) {
    const F f = launder(fin);
    const bf16_t* z = (const bf16_t*)(f.ws + WS_Z);
    bf16_t* cqn = (bf16_t*)(f.ws + WS_CQN); bf16_t* ckva = (bf16_t*)(f.ws + WS_CKVA); bf16_t* kpea = (bf16_t*)(f.ws + WS_KPEA); bf16_t* xcv = (bf16_t*)(f.ws + WS_XCV);
    const float* rc = (const float*)(f.ws + WS_ROPE); const float* rs = rc + 64 * 16;
    const int tid = f.tid, wave = tid >> 6, lane = tid & 63, c8 = lane * 8;
    for (int t = f.bid * 8 + wave; t < NT; t += f.nb * 8) {
        const bf16_t* zr = z + (size_t)t * LDZ;
        const bool ctx = t < NCTX; const int s = ctx ? (t >> 8) : 16 + ((t - NCTX) >> 12); const int tt = t - seq_base(s), T = seq_len(s);
        const int kr = kv_row_of_tok(t);
#pragma unroll
        for (int which = 0; which < 2; ++which) {
            const u32x4_t raw = *(const u32x4_t*)(zr + (which ? ZCKV : ZCQ) + c8); const unsigned rw[4] = {raw.x, raw.y, raw.z, raw.w};
            float v[8]; float ss = 0.f;
#pragma unroll
            for (int j = 0; j < 4; ++j) { v[2 * j] = __uint_as_float(rw[j] << 16); v[2 * j + 1] = __uint_as_float(rw[j] & 0xffff0000u); ss += v[2 * j] * v[2 * j] + v[2 * j + 1] * v[2 * j + 1]; }
            for (int o = 32; o >= 1; o >>= 1) ss += __shfl_xor(ss, o);
            const float rr = rsqrtf(ss * (1.0f / 512.0f) + 1e-6f); const float* gp = (which ? f.in[I_KVNG] : f.in[I_QNG]) + l * 512 + c8;
            const f32x4_t g0 = *(const f32x4_t*)gp, g1 = *(const f32x4_t*)(gp + 4);
            const f32x4_t o0 = {v[0] * rr * g0[0], v[1] * rr * g0[1], v[2] * rr * g0[2], v[3] * rr * g0[3]}, o1 = {v[4] * rr * g1[0], v[5] * rr * g1[1], v[6] * rr * g1[2], v[7] * rr * g1[3]};
            u32x4_t w = {cvtpk2(o0[0], o0[1]), cvtpk2(o0[2], o0[3]), cvtpk2(o1[0], o1[1]), cvtpk2(o1[2], o1[3])};
            if (which == 0) *(u32x4_t*)(cqn + (size_t)t * 512 + c8) = w;
            else { *(u32x4_t*)(ckva + (size_t)kr * 512 + c8) = w;
                if (ctx) { float* op = f.out + O_CKV + ((size_t)((t >> 8) * 2 + l) * 256 + tt) * 512 + c8; *(f32x4_t*)op = o0; *(f32x4_t*)(op + 4) = o1; } }
        }
        {
            const float v = bf2f(zr[ZKPE + lane]);
            if (ctx) { kpea[(size_t)kr * 64 + lane] = f2bf(v); f.out[O_KPE + ((size_t)((t >> 8) * 2 + l) * 256 + tt) * 64 + lane] = v; }
            else {
                const int part = lane >> 5, w = lane & 31, j = w & 15; const int pos = part ? (tt & 63) : (tt >> 6);
                const float x1 = bf2f(zr[ZKPE + part * 32 + j]), x2 = bf2f(zr[ZKPE + part * 32 + 16 + j]);
                const float c = rc[pos * 16 + j], sn = rs[pos * 16 + j];
                kpea[(size_t)kr * 64 + lane] = f2bf(w < 16 ? x1 * c - x2 * sn : x2 * c + x1 * sn);
            }
        }
        {
            f32x4_t a0 = *(const f32x4_t*)(f.in[I_CONVB] + l * 512 + c8), a1 = *(const f32x4_t*)(f.in[I_CONVB] + l * 512 + c8 + 4);
#pragma unroll
            for (int k = 0; k < 4; ++k) { const int u = tt + k - 2; if (u >= 0 && u < T) {
                    const u32x4_t raw = *(const u32x4_t*)(z + (size_t)(t + k - 2) * LDZ + ZXR + c8); const float* wp = f.in[I_CONVW] + (l * 4 + k) * 512 + c8;
                    const f32x4_t w0 = *(const f32x4_t*)wp, w1 = *(const f32x4_t*)(wp + 4);
                    a0[0] += w0[0] * __uint_as_float(raw.x << 16); a0[1] += w0[1] * __uint_as_float(raw.x & 0xffff0000u); a0[2] += w0[2] * __uint_as_float(raw.y << 16); a0[3] += w0[3] * __uint_as_float(raw.y & 0xffff0000u);
                    a1[0] += w1[0] * __uint_as_float(raw.z << 16); a1[1] += w1[1] * __uint_as_float(raw.z & 0xffff0000u); a1[2] += w1[2] * __uint_as_float(raw.w << 16); a1[3] += w1[3] * __uint_as_float(raw.w & 0xffff0000u); } }
            { const u32x4_t w = {cvtpk2(a0[0], a0[1]), cvtpk2(a0[2], a0[3]), cvtpk2(a1[0], a1[1]), cvtpk2(a1[2], a1[3])}; *(u32x4_t*)(xcv + (size_t)t * 512 + c8) = w; }
        }
    }
    for (int i = f.bid * NTHR + tid; i < 2 * PAST * 512; i += f.nb * NTHR) {
        const int b = i / (PAST * 512), r = i % (PAST * 512), j = r / 512, c = r % 512;
        ckva[(size_t)(NCTX + b * (SEQL + PAST) + SEQL + j) * 512 + c] = f2bf(f.in[I_CCKV][(((size_t)b * 2 + l) * PAST + j) * 512 + c]);
    }
    for (int i = f.bid * NTHR + tid; i < 2 * PAST * 64; i += f.nb * NTHR) {
        const int b = i / (PAST * 64), r = i % (PAST * 64), j = r / 64, c = r % 64;
        kpea[(size_t)(NCTX + b * (SEQL + PAST) + SEQL + j) * 64 + c] = f2bf(f.in[I_CKPE][(((size_t)b * 2 + l) * PAST + j) * 64 + c]);
    }
}

namespace att {
using bf16x8 = __attribute__((ext_vector_type(8))) short;
using s16x4  = __attribute__((ext_vector_type(4))) short;
using f32x16 = __attribute__((ext_vector_type(16))) float;
using u32x4  = __attribute__((ext_vector_type(4))) unsigned;
constexpr int NW = 8, QBLK = 32, KVBLK = 64, DQK = 192, DV = 128, LDQ = 1536, LDK = 1024, LDP = 64, LDO = DM;
constexpr float SCALE = 0.07216878364870322f, THR = 8.f;
constexpr size_t SHM_V = KVBLK * DV * 2, SHM_K = KVBLK * DQK * 2;
#define AKSWZ(row, colB) ((row) * 384 + ((colB) ^ (((row) & 7) << 4)))
#define ASBAR() __builtin_amdgcn_sched_barrier(0)
__device__ __forceinline__ int crow(int r, int hi) { return (r & 3) + 8 * (r >> 2) + 4 * hi; }
__device__ __forceinline__ unsigned cvtpk(float lo, float hi) { unsigned r; asm volatile("v_cvt_pk_bf16_f32 %0, %1, %2" : "=v"(r) : "v"(lo), "v"(hi)); return r; }
__device__ __forceinline__ void partialSM(f32x16& p0, f32x16& p1, float& m_reg, float& mn, float& alpha) {
  constexpr float C = SCALE * 1.4426950408889634f;
  float pmax = p0[0]; for (int r = 1; r < 16; ++r) pmax = fmaxf(pmax, p0[r]); for (int r = 0; r < 16; ++r) pmax = fmaxf(pmax, p1[r]);
  { auto rr = __builtin_amdgcn_permlane32_swap(__float_as_uint(pmax), __float_as_uint(pmax), false, false);
    pmax = fmaxf(__uint_as_float(rr[0]), __uint_as_float(rr[1])); }
  if (__builtin_expect(__all(pmax - m_reg <= THR / SCALE), 1)) { mn = m_reg; alpha = 1.f; }
  else { mn = fmaxf(m_reg, pmax); alpha = __builtin_amdgcn_exp2f((m_reg - mn) * C); m_reg = mn; }
  float mnC = -mn * C;
  for (int r = 0; r < 16; ++r) p0[r] = fmaf(p0[r], C, mnC); for (int r = 0; r < 16; ++r) p1[r] = fmaf(p1[r], C, mnC);
  for (int r = 0; r < 16; ++r) p0[r] = __builtin_amdgcn_exp2f(p0[r]);
}
__device__ __forceinline__ void finishSM(f32x16& p0, f32x16& p1, float alpha, float& l_reg, bf16x8& pa0, bf16x8& pa1, bf16x8& pa2, bf16x8& pa3) {
  for (int r = 0; r < 16; ++r) p1[r] = __builtin_amdgcn_exp2f(p1[r]);
  float ps = 0; for (int r = 0; r < 16; ++r) ps += p0[r]; for (int r = 0; r < 16; ++r) ps += p1[r];
  { auto rr = __builtin_amdgcn_permlane32_swap(__float_as_uint(ps), __float_as_uint(ps), false, false);
    ps = __uint_as_float(rr[0]) + __uint_as_float(rr[1]); }
  l_reg = l_reg * alpha + ps;
#define APK4(P, BASE, OUT) do { unsigned a0 = cvtpk(P[BASE + 0], P[BASE + 1]), a1 = cvtpk(P[BASE + 2], P[BASE + 3]);   \
    unsigned b0 = cvtpk(P[BASE + 4], P[BASE + 5]), b1 = cvtpk(P[BASE + 6], P[BASE + 7]);                              \
    auto r0 = __builtin_amdgcn_permlane32_swap(a0, b0, false, false); auto r1 = __builtin_amdgcn_permlane32_swap(a1, b1, false, false); \
    u32x4 w = {r0[0], r1[0], r0[1], r1[1]}; OUT = *reinterpret_cast<bf16x8*>(&w); } while (0)
  APK4(p0, 0, pa0); APK4(p0, 8, pa1); APK4(p1, 0, pa2); APK4(p1, 8, pa3);
#undef APK4
}
__device__ __forceinline__ void qkt(f32x16& p0, f32x16& p1, const char* Ks, const bf16x8* qr, const int (&kb)[4]) {
  p0 = f32x16{}; p1 = f32x16{};
#pragma unroll
  for (int d0 = 0; d0 < 12; ++d0) { const char* ka = Ks + kb[d0 & 3] + (d0 >> 2) * 128;
    bf16x8 b0 = *reinterpret_cast<const bf16x8*>(ka);
    bf16x8 b1 = *reinterpret_cast<const bf16x8*>(ka + 12288);
    p0 = __builtin_amdgcn_mfma_f32_32x32x16_bf16(b0, qr[d0], p0, 0, 0, 0);
    p1 = __builtin_amdgcn_mfma_f32_32x32x16_bf16(b1, qr[d0], p1, 0, 0, 0); }
}
__device__ __forceinline__ int v_st(int k, int c) { const int kk = (k & ~0xC) | ((k & 4) << 1) | ((k & 8) >> 1); return ((kk >> 3) * 4 + (c >> 5)) * 512 + ((kk & 7) * 32 + (c & 31)) * 2; }
__device__ __forceinline__ int v_rd_base(int lane) { return ((lane & 3) << 3) | (((lane >> 2) & 3) << 6) | (((lane >> 4) & 1) << 5) | (((lane >> 5) & 1) << 8); }
constexpr int v_rd_off(int d0, int ks, int half) { return d0 * 512 + ks * 4096 + half * 2048; }
template <int OFF> __device__ __forceinline__ s16x4 tr_read(int vb) {
  s16x4 r; asm volatile("ds_read_b64_tr_b16 %0, %1 offset:%2" : "=&v"(r) : "v"(vb), "i"(OFF) : "memory"); return r;
}
template <int D0> __device__ __forceinline__ void pv_one(f32x16& od, int vb, bf16x8 pa0, bf16x8 pa1, bf16x8 pa2, bf16x8 pa3) {
  const s16x4 l0 = tr_read<v_rd_off(D0, 0, 0)>(vb), h0 = tr_read<v_rd_off(D0, 0, 1)>(vb), l1 = tr_read<v_rd_off(D0, 1, 0)>(vb), h1 = tr_read<v_rd_off(D0, 1, 1)>(vb);
  const s16x4 l2 = tr_read<v_rd_off(D0, 2, 0)>(vb), h2 = tr_read<v_rd_off(D0, 2, 1)>(vb), l3 = tr_read<v_rd_off(D0, 3, 0)>(vb), h3 = tr_read<v_rd_off(D0, 3, 1)>(vb);
  asm volatile("s_waitcnt lgkmcnt(0)" ::: "memory"); ASBAR();
#define APK(L, H) (bf16x8){L[0], L[1], L[2], L[3], H[0], H[1], H[2], H[3]}
  od = __builtin_amdgcn_mfma_f32_32x32x16_bf16(pa0, APK(l0, h0), od, 0, 0, 0);
  od = __builtin_amdgcn_mfma_f32_32x32x16_bf16(pa1, APK(l1, h1), od, 0, 0, 0);
  od = __builtin_amdgcn_mfma_f32_32x32x16_bf16(pa2, APK(l2, h2), od, 0, 0, 0);
  od = __builtin_amdgcn_mfma_f32_32x32x16_bf16(pa3, APK(l3, h3), od, 0, 0, 0);
#undef APK
}
__device__ __forceinline__ void pv_d0(f32x16* o, int vb, bf16x8 pa0, bf16x8 pa1, bf16x8 pa2, bf16x8 pa3) {
  pv_one<0>(o[0], vb, pa0, pa1, pa2, pa3); pv_one<1>(o[1], vb, pa0, pa1, pa2, pa3); pv_one<2>(o[2], vb, pa0, pa1, pa2, pa3); pv_one<3>(o[3], vb, pa0, pa1, pa2, pa3);
}
constexpr int V_OFF = 0, K_OFF = 3 * (int)SHM_V, WS_OFF = K_OFF + 3 * (int)SHM_K, ATT_LDS = WS_OFF + NW * 64 * 4;
#define ABAR() do { asm volatile("" ::: "memory"); __builtin_amdgcn_s_barrier(); asm volatile("" ::: "memory"); } while (0)
template <int MODE>
__device__ __forceinline__ void attn_body(const bf16_t* __restrict__ Qb, const bf16_t* __restrict__ Kn, const bf16_t* __restrict__ Kp, const bf16_t* __restrict__ Vh,
                                          bf16_t* __restrict__ Ob, int seq, int tt0, int rope, const float* __restrict__ rc, const float* __restrict__ rs, LAS unsigned char* ldsl, int tid) {
  char* lds = (char*)ldsl;
  const int wid = __builtin_amdgcn_readfirstlane(tid >> 6), lane = tid & 63, r32 = lane & 31, hi = lane >> 5;
  char* V_lds = lds + V_OFF; char* K_lds = lds + K_OFF;
  float* ws = (float*)(lds + WS_OFF) + wid * 64; float* li_l = ws; float* al_l = ws + 32;
  float m_reg = -1e30f, l_reg = 0; f32x16 o[4] = {}; bf16x8 qr[12];
  const bf16_t* Qw = Qb + (long)(wid * QBLK + r32) * LDQ + hi * 8;
#pragma unroll
  for (int d0 = 0; d0 < 12; ++d0) qr[d0] = *reinterpret_cast<const bf16x8*>(Qw + d0 * 16);
  if (rope) {
    const int tt = tt0 + wid * QBLK + r32;
#pragma unroll
    for (int part = 0; part < 2; ++part) {
      const int pos = part ? (tt & 63) : (tt >> 6);
      const float* cp = rc + pos * 16 + hi * 8; const float* sp = rs + pos * 16 + hi * 8;
      const bf16x8 x1 = qr[8 + 2 * part], x2 = qr[9 + 2 * part];
      float y1[8], y2[8];
#pragma unroll
      for (int i = 0; i < 8; ++i) { const float a = bf2f((bf16_t)x1[i]), b = bf2f((bf16_t)x2[i]), c = cp[i], sn = sp[i]; y1[i] = a * c - b * sn; y2[i] = b * c + a * sn; }
      u32x4 w1 = {cvtpk(y1[0], y1[1]), cvtpk(y1[2], y1[3]), cvtpk(y1[4], y1[5]), cvtpk(y1[6], y1[7])};
      u32x4 w2 = {cvtpk(y2[0], y2[1]), cvtpk(y2[2], y2[3]), cvtpk(y2[4], y2[5]), cvtpk(y2[6], y2[7])};
      qr[8 + 2 * part] = *reinterpret_cast<bf16x8*>(&w1); qr[9 + 2 * part] = *reinterpret_cast<bf16x8*>(&w2);
    }
  }
  int koff[3], voff[2];
#pragma unroll
  for (int i = 0; i < 3; ++i) { const int p = (wid + 8 * i) * 64 + lane, row = p / 24, slot = p % 24, ch = (slot & ~7) | ((slot ^ row) & 7);
    koff[i] = ch >= 16 ? (int)(((unsigned)(row * LDP + (ch - 16) * 8) * 2u) | 0x80000000u) : (row * LDK + ch * 8) * 2; }
#pragma unroll
  for (int i = 0; i < 2; ++i) { const int p = (wid + 8 * i) * 64 + lane, sub = p >> 5, w = p & 31, kk = (sub >> 2) * 8 + (w >> 2), k = (kk & ~0xC) | ((kk & 4) << 1) | ((kk & 8) >> 1), c = (sub & 3) * 32 + (w & 3) * 8;
    voff[i] = (k * LDK + c) * 2; }
  LAS unsigned char* const kl0 = ldsl + K_OFF + wid * 1024; LAS unsigned char* const vl0 = ldsl + V_OFF + wid * 1024;
  int dtK = 0, dtV = 0;
#define ADMA_K(b) do { if (MODE == 2) break; const char* kn_t = (const char*)Kn + (long)dtK * (KVBLK * LDK * 2); const char* kp_t = (const char*)Kp + (long)dtK * (KVBLK * LDP * 2); \
    _Pragma("unroll") for (int _i = 0; _i < 3; ++_i) { const char* src_ = (koff[_i] < 0 ? kp_t : kn_t) + (koff[_i] & 0x7fffffff); \
        __builtin_amdgcn_global_load_lds((const unsigned*)src_, (LAS unsigned*)(kl0 + (b) * (int)SHM_K + _i * 8192), 16, 0, 0); } ++dtK; } while (0)
#define ADMA_V(b) do { if (MODE == 2) break; const char* v_t = (const char*)Vh + (long)dtV * (KVBLK * LDK * 2); \
    _Pragma("unroll") for (int _i = 0; _i < 2; ++_i) __builtin_amdgcn_global_load_lds((const unsigned*)(v_t + voff[_i]), (LAS unsigned*)(vl0 + (b) * (int)SHM_V + _i * 8192), 16, 0, 0); ++dtV; } while (0)
#define AWAITN(allow) do { if ((allow) >= 10) asm volatile("s_waitcnt vmcnt(10)" ::: "memory"); else if ((allow) >= 5) asm volatile("s_waitcnt vmcnt(5)" ::: "memory"); else asm volatile("s_waitcnt vmcnt(0)" ::: "memory"); } while (0)
#define ARESC(a) do { if (__any((a) < 1.f)) { if (hi == 0) al_l[r32] = (a); asm volatile("s_waitcnt lgkmcnt(0)" ::: "memory"); \
    for (int d = 0; d < 4; ++d) for (int r = 0; r < 16; ++r) o[d][r] *= al_l[crow(r, hi)]; } } while (0)
  const int vbase = (int)(uintptr_t)V_lds + v_rd_base(lane);
  int kb[4];
#pragma unroll
  for (int b = 0; b < 4; ++b) kb[b] = AKSWZ(r32, (b * 16 + hi * 8) * 2);
  f32x16 pA0, pA1, pB0, pB1; float mnA, mnB, alA, alB; bf16x8 pa0, pa1, pa2, pa3; const int NT_ = seq / KVBLK;
  __syncthreads();
  ADMA_K(0); ADMA_V(0); ADMA_K(1); ADMA_V(1); ADMA_K(2); ADMA_V(2);
  AWAITN(10); ABAR();
  qkt(pA0, pA1, K_lds, qr, kb); partialSM(pA0, pA1, m_reg, mnA, alA);
  ABAR();
  ADMA_K(0);
  AWAITN(10); ABAR();
  int bp = 0, bc = 1, bn = 2;
  int prevn = 5;
  for (int j = 1; j + 1 < NT_; j += 2) {
    ASBAR(); qkt(pB0, pB1, K_lds + bc * (int)SHM_K, qr, kb);
    finishSM(pA0, pA1, alA, l_reg, pa0, pa1, pa2, pa3); ASBAR();
    pv_d0(o, vbase + bp * (int)SHM_V, pa0, pa1, pa2, pa3); partialSM(pB0, pB1, m_reg, mnB, alB);
    ABAR();
    int curn = 0;
    if (j + 3 < NT_) { ADMA_K(bc); curn += 3; }
    if (j + 2 < NT_) { ADMA_V(bp); curn += 2; }
    AWAITN(prevn + curn); ARESC(alB); ABAR();
    prevn = curn;
    ASBAR(); qkt(pA0, pA1, K_lds + bn * (int)SHM_K, qr, kb);
    finishSM(pB0, pB1, alB, l_reg, pa0, pa1, pa2, pa3); ASBAR();
    pv_d0(o, vbase + bc * (int)SHM_V, pa0, pa1, pa2, pa3); partialSM(pA0, pA1, m_reg, mnA, alA);
    ABAR();
    curn = 0;
    if (j + 4 < NT_) { ADMA_K(bn); curn += 3; }
    if (j + 3 < NT_) { ADMA_V(bc); curn += 2; }
    AWAITN(prevn + curn); ARESC(alA); ABAR();
    prevn = curn;
    const int t_ = bp; bp = bn; bn = bc; bc = t_;
  }
  AWAITN(0);
  ASBAR(); qkt(pB0, pB1, K_lds + bc * (int)SHM_K, qr, kb);
  finishSM(pA0, pA1, alA, l_reg, pa0, pa1, pa2, pa3); ASBAR();
  pv_d0(o, vbase + bp * (int)SHM_V, pa0, pa1, pa2, pa3); partialSM(pB0, pB1, m_reg, mnB, alB);
  ARESC(alB);
  finishSM(pB0, pB1, alB, l_reg, pa0, pa1, pa2, pa3); ASBAR();
  pv_d0(o, vbase + bc * (int)SHM_V, pa0, pa1, pa2, pa3);
  if (hi == 0) li_l[r32] = l_reg; asm volatile("s_waitcnt lgkmcnt(0)" ::: "memory");
  float rli[16];
#pragma unroll
  for (int r = 0; r < 16; ++r) rli[r] = __builtin_amdgcn_rcpf(li_l[crow(r, hi)]);
  bf16_t* Ow = Ob + (long)(wid * QBLK) * LDO;
#pragma unroll
  for (int r = 0; r < 16; ++r) { int orow = crow(r, hi);
    for (int d0 = 0; d0 < 4; ++d0) { if (MODE == 0 || o[d0][r] * rli[r] == 1.2345e30f) Ow[(long)orow * LDO + d0 * 32 + r32] = f2bf(o[d0][r] * rli[r]); } }
#undef ADMA_K
#undef ADMA_V
#undef AWAITN
#undef ARESC
}
}
template <int MODE>
__device__ __forceinline__ void attn_unit(const F& f, int s, int h, int qb) {
    const bf16_t* qm = (const bf16_t*)(f.ws + WS_QM); const bf16_t* kn = (const bf16_t*)(f.ws + WS_KN); const bf16_t* vv = (const bf16_t*)(f.ws + WS_VV);
    const bf16_t* kpea = (const bf16_t*)(f.ws + WS_KPEA); bf16_t* omix = (bf16_t*)(f.ws + WS_OMIX);
    const float* rc = (const float*)(f.ws + WS_ROPE); const float* rs = rc + 64 * 16;
    const int t0 = seq_base(s) + qb * 256, kb = kv_base(s);
    att::attn_body<MODE>(qm + (size_t)t0 * 1536 + h * 192, kn + (size_t)kb * 1024 + h * 128, kpea + (size_t)kb * 64, vv + (size_t)kb * 1024 + h * 128,
                   omix + (size_t)t0 * DM + 1024 + h * 128, kv_len(s), qb * 256, s >= 16 ? 1 : 0, rc, rs, (LAS unsigned char*)f.lds, f.tid);
}

typedef short bf16x8_t __attribute__((ext_vector_type(8)));
__device__ __forceinline__ void ph_rgw(const F& f) {
    bf16_t* wt = (bf16_t*)(f.ws + WS_WRG);
    { float* rt = (float*)(f.ws + WS_RT); for (int idx = f.bid * NTHR + f.tid; idx < 2 * 16 * DM; idx += f.nb * NTHR) { const int c = idx % DM, e = (idx / DM) & 15, l = idx / (16 * DM); rt[idx] = f.in[I_ROUT][((size_t)l * DM + c) * 16 + e]; } }
    for (int idx = f.bid * NTHR + f.tid; idx < 16 * 2 * 128 * 128; idx += f.nb * NTHR) {
        const int i = idx & 127, j = (idx >> 7) & 127, g = (idx >> 14) & 1, m = idx >> 15;
        const float* src = (g ? f.in[I_WI] : f.in[I_WR]) + (size_t)m * 16384;
        wt[idx] = f2bf(src[i * 128 + j]);
    }
}
__device__ __forceinline__ void rg_unit(const F& f, int l, int dir, int h, int tile) {
    const bf16_t* xcv = (const bf16_t*)(f.ws + WS_XCV);
    bf16_t* PP = (bf16_t*)(f.ws + WS_RGA) + (size_t)dir * NT * 512; bf16_t* HL = (bf16_t*)(f.ws + WS_RGX) + (size_t)dir * NT * 512;
    float* ATOT = (float*)(f.ws + WS_RGC) + (size_t)dir * 192 * 512; float* HEND = ATOT + 2 * 192 * 512;
    const bf16_t* wt = (const bf16_t*)(f.ws + WS_WRG) + ((size_t)((l * 2 + dir) * 4 + h)) * 2 * 16384;
    char* Wl = (char*)f.lds;
    float* XC = (float*)(f.lds + 2 * 128 * 272);
    float* WT = (float*)(f.lds + 2 * 128 * 272 + 128 * 528);
    const int tid = f.tid, wid = tid >> 6, lane = tid & 63, lr = lane & 15, lg = lane >> 4;
    __syncthreads();
#pragma unroll
    for (int i = 0; i < 8; ++i) { const int c = tid + i * 512, row = c >> 4, ch = c & 15;
        *(u32x4_t*)(Wl + row * 272 + ch * 16) = *(const u32x4_t*)(wt + (size_t)row * 128 + ch * 8); }
#pragma unroll
    for (int i = 0; i < 8; ++i) { const int c = tid + i * 512, row = c >> 5, ch = c & 31; const int tok = tile * 128 + (dir ? 127 - row : row);
        typedef unsigned u32x2_t __attribute__((ext_vector_type(2))); const u32x2_t xr = *(const u32x2_t*)(xcv + (size_t)tok * 512 + h * 128 + ch * 4);
        *(f32x4_t*)(XC + row * 132 + ch * 4) = (f32x4_t){__uint_as_float(xr.x << 16), __uint_as_float(xr.x & 0xffff0000u), __uint_as_float(xr.y << 16), __uint_as_float(xr.y & 0xffff0000u)}; }
    __syncthreads();
    bf16x8_t af[4];
#pragma unroll
    for (int ks = 0; ks < 4; ++ks) { const float* p = XC + (wid * 16 + lr) * 132 + ks * 32 + lg * 8; const f32x4_t x0 = *(const f32x4_t*)p, x1 = *(const f32x4_t*)(p + 4);
        u32x4_t w = {cvtpk2(x0[0], x0[1]), cvtpk2(x0[2], x0[3]), cvtpk2(x1[0], x1[1]), cvtpk2(x1[2], x1[3])}; af[ks] = *reinterpret_cast<bf16x8_t*>(&w); }
    f32x4_t ar[8], ai[8];
#pragma unroll
    for (int nb = 0; nb < 8; ++nb) { ar[nb] = (f32x4_t){0.f, 0.f, 0.f, 0.f}; ai[nb] = (f32x4_t){0.f, 0.f, 0.f, 0.f}; }
#pragma unroll
    for (int nb = 0; nb < 8; ++nb)
#pragma unroll
        for (int ks = 0; ks < 4; ++ks) {
            const bf16x8_t br = *(const bf16x8_t*)(Wl + (nb * 16 + lr) * 272 + (ks * 32 + lg * 8) * 2);
            const bf16x8_t bi = *(const bf16x8_t*)(Wl + (128 + nb * 16 + lr) * 272 + (ks * 32 + lg * 8) * 2);
            ar[nb] = __builtin_amdgcn_mfma_f32_16x16x32_bf16(af[ks], br, ar[nb], 0, 0, 0);
            ai[nb] = __builtin_amdgcn_mfma_f32_16x16x32_bf16(af[ks], bi, ai[nb], 0, 0, 0);
            if (ks == 3 && (nb & 1)) __builtin_amdgcn_sched_barrier(0);
        }
    const int cb = (l * 2 + dir) * 512 + h * 128;
#pragma unroll
    for (int nb = 0; nb < 8; ++nb) {
        const int c = nb * 16 + lr; const float br = f.in[I_BR][cb + c], bi = f.in[I_BI][cb + c], sp = __logf(1.0f + __expf(-f.in[I_LAM][cb + c])) * -8.0f;
        float P = 1.f, H = 0.f;
#pragma unroll
        for (int i = 0; i < 4; ++i) {
            const float xc = XC[(wid * 16 + lg * 4 + i) * 132 + c];
            const float r = __builtin_amdgcn_rcpf(1.0f + __expf(-(ar[nb][i] + br))), ig = __builtin_amdgcn_rcpf(1.0f + __expf(-(ai[nb][i] + bi)));
            const float la = sp * r, a = __expf(la), x = __builtin_amdgcn_sqrtf(fmaxf(1.0f - a * a, 0.f)) * (ig * xc);
            P *= a; H = a * H + x; ar[nb][i] = P; ai[nb][i] = H;
        }
        float cA = 1.f, cH = 0.f, tA = 1.f, tH = 0.f;
#pragma unroll
        for (int g = 0; g < 4; ++g) { const float gA = __shfl(P, lr + 16 * g), gH = __shfl(H, lr + 16 * g);
            if (g < lg) { cH = gA * cH + gH; cA *= gA; }
            tH = gA * tH + gH; tA *= gA; }
#pragma unroll
        for (int i = 0; i < 4; ++i) { ai[nb][i] += ar[nb][i] * cH; ar[nb][i] *= cA; }
        if (lg == 0) { WT[(wid * 128 + nb * 16 + lr) * 2] = tA; WT[(wid * 128 + nb * 16 + lr) * 2 + 1] = tH; }
    }
    __syncthreads();
    const int w0 = wid & 4;
#pragma unroll
    for (int nb = 0; nb < 8; ++nb) {
        const int c = nb * 16 + lr; float cA = 1.f, cH = 0.f;
        for (int w = w0; w < wid; ++w) { const float gA = WT[(w * 128 + c) * 2], gH = WT[(w * 128 + c) * 2 + 1]; cH = gA * cH + gH; cA *= gA; }
#pragma unroll
        for (int i = 0; i < 4; ++i) {
            const int pos = wid * 16 + lg * 4 + i;
            const float Hf = ai[nb][i] + ar[nb][i] * cH, Pf = ar[nb][i] * cA;
            *(bf16_t*)(Wl + pos * 272 + c * 2) = f2bf(Pf); *(bf16_t*)(Wl + 128 * 272 + pos * 272 + c * 2) = f2bf(Hf);
            if ((wid & 3) == 3 && lg == 3 && i == 3) { const int tok = tile * 128 + (dir ? 127 - pos : pos); const int chunk = tok >> 6; ATOT[(size_t)chunk * 512 + h * 128 + c] = Pf; HEND[(size_t)chunk * 512 + h * 128 + c] = Hf; }
        }
    }
    __syncthreads();
#pragma unroll
    for (int i = 0; i < 8; ++i) { const int c = tid + i * 512, arr = c >> 11, r = c & 2047, row = r >> 4, ch = r & 15; const int tok = tile * 128 + (dir ? 127 - row : row);
        *(u32x4_t*)((arr ? HL : PP) + (size_t)tok * 512 + h * 128 + ch * 8) = *(const u32x4_t*)(Wl + arr * 128 * 272 + row * 272 + ch * 16); }
}
__device__ __forceinline__ void rg_passB(const F& f, int l, int idx) {
    const int c = idx & 511, dir = (idx >> 9) & 1, s = idx >> 10;
    const float* ATOT = (const float*)(f.ws + WS_RGC) + (size_t)dir * 192 * 512; const float* HEND = ATOT + 2 * 192 * 512; float* CIN = (float*)(f.ws + WS_RGC) + (size_t)(4 + dir) * 192 * 512;
    const int c0 = seq_base(s) >> 6, n = seq_len(s) >> 6;
    float hcar = s >= 16 ? f.in[I_SRG][(((size_t)(s - 16) * 2 + l) * 2 + dir) * 512 + c] : 0.f;
#pragma unroll 8
    for (int k = 0; k < n; ++k) { const int ch = c0 + (dir ? n - 1 - k : k); CIN[(size_t)ch * 512 + c] = hcar; hcar = ATOT[(size_t)ch * 512 + c] * hcar + HEND[(size_t)ch * 512 + c]; }
    if (s < 16) f.out[O_RG + (((size_t)s * 2 + l) * 2 + dir) * 512 + c] = hcar;
}
__device__ __forceinline__ void rg_passC(const F& f) {
    const bf16_t* z = (const bf16_t*)(f.ws + WS_Z); bf16_t* omix = (bf16_t*)(f.ws + WS_OMIX);
    const bf16_t* PP = (const bf16_t*)(f.ws + WS_RGA); const bf16_t* HL = (const bf16_t*)(f.ws + WS_RGX); const float* CIN = (const float*)(f.ws + WS_RGC) + (size_t)4 * 192 * 512;
    typedef unsigned u32x2_t __attribute__((ext_vector_type(2)));
#pragma unroll 3
    for (int idx = f.bid * NTHR + f.tid; idx < NT * 128; idx += f.nb * NTHR) {
        const int t = idx >> 7, c4 = (idx & 127) * 4, chunk = t >> 6;
        const u32x2_t pfr = *(const u32x2_t*)(PP + (size_t)t * 512 + c4), hfr = *(const u32x2_t*)(HL + (size_t)t * 512 + c4);
        const u32x2_t pbr = *(const u32x2_t*)(PP + (size_t)NT * 512 + (size_t)t * 512 + c4), hbr = *(const u32x2_t*)(HL + (size_t)NT * 512 + (size_t)t * 512 + c4);
        const f32x4_t cf = *(const f32x4_t*)(CIN + (size_t)chunk * 512 + c4), cbk = *(const f32x4_t*)(CIN + (size_t)(192 + chunk) * 512 + c4);
#define U2F(r) (f32x4_t){__uint_as_float((r).x << 16), __uint_as_float((r).x & 0xffff0000u), __uint_as_float((r).y << 16), __uint_as_float((r).y & 0xffff0000u)}
        const f32x4_t hsum = (U2F(hfr) + U2F(pfr) * cf) + (U2F(hbr) + U2F(pbr) * cbk);
#undef U2F
        const u32x2_t yr = *(const u32x2_t*)(z + (size_t)t * LDZ + ZYR + c4);
        u32x2_t w; w.x = cvtpk2(hsum[0] * gelu_tanh_(__uint_as_float(yr.x << 16)), hsum[1] * gelu_tanh_(__uint_as_float(yr.x & 0xffff0000u))); w.y = cvtpk2(hsum[2] * gelu_tanh_(__uint_as_float(yr.y << 16)), hsum[3] * gelu_tanh_(__uint_as_float(yr.y & 0xffff0000u)));
        *(u32x2_t*)(omix + (size_t)t * DM + 512 + c4) = w;
    }
}

__device__ __forceinline__ void ph_rg_units(const F& fin, int l) {
    const F f = launder(fin);
    for (int k = 0;; ++k) { const int u = xcd_deal(f, k, 2 * 4 * 96); if (u < 0) break; const int tile = u >> 3, dh = u & 7; rg_unit(f, l, dh >> 2, dh & 3, tile); }
    __syncthreads();
}

namespace hg {
constexpr int QP_OFF = 0, KP_OFF = 17408, KT_OFF = 34816, VT_OFF = 53248, DEC_OFF = 71680, CL_OFF = 73728, ST_OFF = 75776, LDS_END = ST_OFF + 8 * 4352;
typedef float f32x4 __attribute__((ext_vector_type(4)));
typedef short bf16x8 __attribute__((ext_vector_type(8)));
typedef short bf16x4 __attribute__((ext_vector_type(4)));
typedef unsigned u32x2 __attribute__((ext_vector_type(2)));
typedef unsigned u32x4 __attribute__((ext_vector_type(4)));
__device__ __forceinline__ void hg_zload(const F& f, int u, u32x4 (&zr)[6]) {
    const bf16_t* z = (const bf16_t*)(f.ws + WS_Z); const int tile = u % 192, dh = u / 192, dir = dh >> 2, h = dh & 3, zf = dir ? ZFB : ZFF;
#pragma unroll
    for (int i = 0; i < 6; ++i) { const int c = f.tid + i * 512, which = c >> 10, r = c & 1023, row = r >> 4, ch = r & 15;
        zr[i] = *(const u32x4*)(z + (size_t)(tile * 64 + row) * LDZ + (which == 0 ? ZQ : which == 1 ? zf : ZI) + h * 128 + ch * 8); }
}
__device__ __forceinline__ void passA(const F& f, int l, int dir, int h, int tile, u32x4 (&zr)[6], int nu) {
    const bf16_t* z = (const bf16_t*)(f.ws + WS_Z);
    const float lbv = ((const float*)(f.ws + WS_LB))[(l * 2 + dir) * 512 + h * 128 + (f.tid & 127)];
    bf16_t* QS = (bf16_t*)(f.ws + WS_QS) + (size_t)dir * NT * 512; bf16_t* OL = (bf16_t*)(f.ws + WS_OHG) + (size_t)dir * NT * 512;
    float* DT = (float*)(f.ws + WS_DT) + ((size_t)(dir * 192 + tile) * 4 + h) * 128;
    bf16_t* DS = (bf16_t*)(f.ws + WS_DS) + ((size_t)(dir * 192 + tile) * 4 + h) * 16384;
    char* L = (char*)f.lds;
    const int tid = f.tid, wid = tid >> 6, lane = tid & 63, lr = lane & 15, lg = lane >> 4;
    const int zf = dir ? ZFB : ZFF;
    __syncthreads();
    {
        char* ZS = L + ST_OFF;
#pragma unroll
        for (int i = 0; i < 6; ++i) { const int c = tid + i * 512, which = c >> 10, r = c & 1023, row = r >> 4, ch = r & 15; *(u32x4*)(ZS + which * 16384 + row * 256 + ch * 16) = zr[i]; }
        if (nu >= 0) hg_zload(f, nu, zr);
        LDS_BARRIER();
        const int d = tid & 127, q4 = tid >> 7;
        float ev[16], kv[16], qv[16]; float cum = 0.f;
#pragma unroll
        for (int i = 0; i < 16; ++i) {
            const int pos = q4 * 16 + i, trow = dir ? 63 - pos : pos; const bf16_t* zr = (const bf16_t*)(ZS + trow * 256) + d;
            const float fv = lbv + (1.0f - lbv) * __builtin_amdgcn_rcpf(1.0f + __expf(-bf2f(zr[8192])));
            cum += __logf(fv); ev[i] = cum; kv[i] = 1.0f - fv; const float qz = bf2f(zr[0]); qv[i] = qz * __builtin_amdgcn_rcpf(1.0f + __expf(-qz));
            *(bf16_t*)(L + VT_OFF + d * 144 + pos * 2) = zr[16384];
        }
        const float cl = cum;
        ((float*)(L + CL_OFF))[q4 * 128 + d] = cl; ((float*)(L + DEC_OFF))[q4 * 128 + d] = __expf(cl);
#pragma unroll
        for (int i = 0; i < 16; ++i) { const int pos = q4 * 16 + i; const float E = __expf(ev[i]), Einv = fminf(__builtin_amdgcn_rcpf(E), 5.5e34f);
            *(bf16_t*)(L + QP_OFF + pos * 272 + d * 2) = f2bf(qv[i] * E);
            *(bf16_t*)(L + KP_OFF + pos * 272 + d * 2) = f2bf(kv[i] * Einv);
            *(bf16_t*)(L + KT_OFF + d * 144 + pos * 2) = f2bf(kv[i] * __expf(cl - ev[i]));
            qv[i] *= E; }
        __syncthreads();
        float off = 0.f;
        for (int p = 0; p < q4; ++p) off += ((const float*)(L + CL_OFF))[p * 128 + d];
        const float eoff = __expf(off);
#pragma unroll
        for (int i = 0; i < 16; ++i) { const int pos = q4 * 16 + i, tok = tile * 64 + (dir ? 63 - pos : pos); QS[(size_t)tok * 512 + h * 128 + d] = f2bf(qv[i] * eoff); }
        if (q4 == 3) DT[d] = __expf(off + cl);
    }
    char* STw = L + ST_OFF + wid * 4352;
    f32x4 Sacc[8];
#pragma unroll
    for (int mb = 0; mb < 8; ++mb) Sacc[mb] = (f32x4){0.f, 0.f, 0.f, 0.f};
#pragma unroll
    for (int q4 = 0; q4 < 4; ++q4) {
        bf16x8 qf[4], kf[4];
#pragma unroll
        for (int ks = 0; ks < 4; ++ks) { qf[ks] = *(const bf16x8*)(L + QP_OFF + (q4 * 16 + lr) * 272 + (ks * 32 + lg * 8) * 2); kf[ks] = *(const bf16x8*)(L + KP_OFF + (q4 * 16 + lr) * 272 + (ks * 32 + lg * 8) * 2); }
        f32x4 at = (f32x4){0.f, 0.f, 0.f, 0.f};
#pragma unroll
        for (int ks = 0; ks < 4; ++ks) at = __builtin_amdgcn_mfma_f32_16x16x32_bf16(kf[ks], qf[ks], at, 0, 0, 0);
#pragma unroll
        for (int i = 0; i < 4; ++i) at[i] = (4 * lg + i <= lr) ? at[i] : 0.f;
        u32x4 pw = {cvtpk2(at[0], at[1]), cvtpk2(at[2], at[3]), 0u, 0u}; const bf16x8 pfrag = *reinterpret_cast<bf16x8*>(&pw);
        const u32x2 vv2 = *(const u32x2*)(L + VT_OFF + (wid * 16 + lr) * 144 + (q4 * 16 + lg * 4) * 2);
        u32x4 vw = {vv2.x, vv2.y, 0u, 0u}; const bf16x8 vfrag = *reinterpret_cast<bf16x8*>(&vw);
        f32x4 oacc = __builtin_amdgcn_mfma_f32_16x16x32_bf16(pfrag, vfrag, (f32x4){0.f, 0.f, 0.f, 0.f}, 0, 0, 0);
        if (q4 > 0) {
#pragma unroll
            for (int ks = 0; ks < 4; ++ks) { const bf16x8 sf = *(const bf16x8*)(STw + lr * 272 + (ks * 32 + lg * 8) * 2); oacc = __builtin_amdgcn_mfma_f32_16x16x32_bf16(qf[ks], sf, oacc, 0, 0, 0); }
        }
#pragma unroll
        for (int i = 0; i < 4; ++i) { const int pos = q4 * 16 + lg * 4 + i, tok = tile * 64 + (dir ? 63 - pos : pos); OL[(size_t)tok * 512 + h * 128 + wid * 16 + lr] = f2bf(oacc[i]); }
        bf16x8 bfr = (bf16x8){0, 0, 0, 0, 0, 0, 0, 0};
        if (lg < 2) bfr = *(const bf16x8*)(L + VT_OFF + (wid * 16 + lr) * 144 + (q4 * 16 + lg * 8) * 2);
#pragma unroll
        for (int mb = 0; mb < 8; ++mb) {
            bf16x8 afr = (bf16x8){0, 0, 0, 0, 0, 0, 0, 0};
            if (lg < 2) afr = *(const bf16x8*)(L + KT_OFF + (mb * 16 + lr) * 144 + (q4 * 16 + lg * 8) * 2);
            const f32x4 dc = *(const f32x4*)(L + DEC_OFF + (q4 * 128 + mb * 16 + lg * 4) * 4);
            Sacc[mb] = __builtin_amdgcn_mfma_f32_16x16x32_bf16(afr, bfr, Sacc[mb] * dc, 0, 0, 0);
        }
        if (q4 < 3) {
            __builtin_amdgcn_sched_barrier(0); asm volatile("s_nop 15\n\ts_nop 15" ::: "memory"); __builtin_amdgcn_sched_barrier(0);
#pragma unroll
            for (int mb = 0; mb < 8; ++mb) { u32x2 w; w.x = cvtpk2(Sacc[mb][0], Sacc[mb][1]); w.y = cvtpk2(Sacc[mb][2], Sacc[mb][3]); *(u32x2*)(STw + lr * 272 + (mb * 16 + lg * 4) * 2) = w; }
            asm volatile("s_waitcnt lgkmcnt(0)" ::: "memory");
        }
    }
    __builtin_amdgcn_sched_barrier(0); asm volatile("s_nop 15\n\ts_nop 15" ::: "memory"); __builtin_amdgcn_sched_barrier(0);
#pragma unroll
    for (int mb = 0; mb < 8; ++mb) { u32x2 w; w.x = cvtpk2(Sacc[mb][0], Sacc[mb][1]); w.y = cvtpk2(Sacc[mb][2], Sacc[mb][3]); *(u32x2*)(DS + (size_t)(wid * 16 + lr) * 128 + mb * 16 + lg * 4) = w; }
}
__device__ __forceinline__ void passB(const F& f, int l, int s, int h, int dir, int qd) {
    const int tid = f.tid, e = qd * 32 + (tid >> 4), d0 = (tid & 15) * 8;
    const int c0 = seq_base(s) >> 6, n = seq_len(s) >> 6;
    float S[8];
    if (s >= 16) { const float* s0 = f.in[I_SHG] + ((((size_t)(s - 16) * 2 + l) * 2 + dir) * 4 + h) * 16384 + e;
#pragma unroll
        for (int j = 0; j < 8; ++j) S[j] = s0[(size_t)(d0 + j) * 128]; }
    else {
#pragma unroll
        for (int j = 0; j < 8; ++j) S[j] = 0.f; }
    const bf16_t* dsb = (const bf16_t*)(f.ws + WS_DS) + (size_t)e * 128 + d0; const float* dtb = (const float*)(f.ws + WS_DT) + d0; bf16_t* ssb = (bf16_t*)(f.ws + WS_SST) + (size_t)e * 128 + d0;
    u32x4 dsA[4], dsB[4]; f32x4 tA[4][2], tB[4][2];
#define HGB_LOAD(DSV, TV, kb) do { _Pragma("unroll") for (int q = 0; q < 4; ++q) { const int kk = (kb) + q; const size_t ubq = ((size_t)(dir * 192 + c0 + (dir ? n - 1 - kk : kk)) * 4 + h); \
        DSV[q] = *(const u32x4*)(dsb + ubq * 16384); TV[q][0] = *(const f32x4*)(dtb + ubq * 128); TV[q][1] = *(const f32x4*)(dtb + ubq * 128 + 4); } } while (0)
#define HGB_STEP(DSV, TV, kb) do { _Pragma("unroll") for (int q = 0; q < 4; ++q) { const int kk = (kb) + q; const size_t ubq = ((size_t)(dir * 192 + c0 + (dir ? n - 1 - kk : kk)) * 4 + h); \
        u32x4 w = {cvtpk2(S[0], S[1]), cvtpk2(S[2], S[3]), cvtpk2(S[4], S[5]), cvtpk2(S[6], S[7])}; *(u32x4*)(ssb + ubq * 16384) = w; \
        const unsigned dw[4] = {DSV[q].x, DSV[q].y, DSV[q].z, DSV[q].w}; const float tv[8] = {TV[q][0][0], TV[q][0][1], TV[q][0][2], TV[q][0][3], TV[q][1][0], TV[q][1][1], TV[q][1][2], TV[q][1][3]}; \
        _Pragma("unroll") for (int j = 0; j < 4; ++j) { S[2 * j] = tv[2 * j] * S[2 * j] + __uint_as_float(dw[j] << 16); S[2 * j + 1] = tv[2 * j + 1] * S[2 * j + 1] + __uint_as_float(dw[j] & 0xffff0000u); } } } while (0)
    HGB_LOAD(dsA, tA, 0);
    for (int k = 0; k < n; k += 8) {
        if (k + 4 < n) HGB_LOAD(dsB, tB, k + 4);
        HGB_STEP(dsA, tA, k);
        if (k + 4 < n) { if (k + 8 < n) HGB_LOAD(dsA, tA, k + 8); HGB_STEP(dsB, tB, k + 4); }
    }
#undef HGB_LOAD
#undef HGB_STEP
    if (s < 16) { float* so = f.out + O_HG + ((((size_t)s * 2 + l) * 2 + dir) * 4 + h) * 16384 + e;
#pragma unroll
        for (int j = 0; j < 8; ++j) so[(size_t)(d0 + j) * 128] = S[j]; }
}
__device__ __forceinline__ void hgc_load(const F& f, int u, u32x4 (&cr)[10]) {
    const int tile = u >> 2, h = u & 3, tid = f.tid;
#pragma unroll
    for (int i = 0; i < 2; ++i) { const int c = tid + i * 512, row = c >> 4, ch = c & 15; const bf16_t* p = (const bf16_t*)(f.ws + WS_OHG) + (size_t)(tile * 64 + row) * 512 + h * 128 + ch * 8;
        cr[2 * i] = *(const u32x4*)p; cr[2 * i + 1] = *(const u32x4*)(p + (size_t)NT * 512); }
#pragma unroll
    for (int i = 0; i < 2; ++i) { const int c = tid + i * 512, row = c >> 4, ch = c & 15; cr[4 + i] = *(const u32x4*)((const bf16_t*)(f.ws + WS_Z) + (size_t)(tile * 64 + row) * LDZ + ZG + h * 128 + ch * 8); }
#pragma unroll
    for (int i = 0; i < 4; ++i) { const int c = tid + i * 512, dir = c >> 10, r = c & 1023, row = r >> 4, ch = r & 15;
        cr[6 + i] = *(const u32x4*)((const bf16_t*)(f.ws + WS_QS) + (size_t)dir * NT * 512 + (size_t)(tile * 64 + row) * 512 + h * 128 + ch * 8); }
}
__device__ __forceinline__ void passC(const F& f, int l, int tile, int h, u32x4 (&cr)[10], int nu) {
    bf16_t* omix = (bf16_t*)(f.ws + WS_OMIX);
    char* L = (char*)f.lds;
    float* OS = (float*)L;
    bf16_t* GZ = (bf16_t*)(L + 64 * 132 * 4);
    float* red = (float*)(L + 64 * 132 * 4 + 64 * 256);
    char* QL = L + 64 * 132 * 4 + 64 * 256 + 2048;
    const int tid = f.tid, wid = tid >> 6, lane = tid & 63, lr = lane & 15, lg = lane >> 4;
    const int ecol = h * 128 + wid * 16 + lr;
    bf16x8 sf[2][4];
#pragma unroll
    for (int dir = 0; dir < 2; ++dir) { const bf16_t* sst = (const bf16_t*)(f.ws + WS_SST) + ((size_t)(dir * 192 + tile) * 4 + h) * 16384 + (size_t)(wid * 16 + lr) * 128;
#pragma unroll
        for (int ks = 0; ks < 4; ++ks) sf[dir][ks] = *(const bf16x8*)(sst + ks * 32 + lg * 8); }
    LDS_BARRIER();
#pragma unroll
    for (int i = 0; i < 2; ++i) { const int c = tid + i * 512, row = c >> 4, ch = c & 15;
        const u32x4 a = cr[2 * i], b = cr[2 * i + 1]; const unsigned aw[4] = {a.x, a.y, a.z, a.w}, bw[4] = {b.x, b.y, b.z, b.w};
#pragma unroll
        for (int j = 0; j < 4; ++j) { OS[row * 132 + ch * 8 + 2 * j] = __uint_as_float(aw[j] << 16) + __uint_as_float(bw[j] << 16); OS[row * 132 + ch * 8 + 2 * j + 1] = __uint_as_float(aw[j] & 0xffff0000u) + __uint_as_float(bw[j] & 0xffff0000u); } }
#pragma unroll
    for (int i = 0; i < 2; ++i) { const int c = tid + i * 512, row = c >> 4, ch = c & 15; *(u32x4*)(GZ + row * 128 + ch * 8) = cr[4 + i]; }
#pragma unroll
    for (int i = 0; i < 4; ++i) { const int c = tid + i * 512, dir = c >> 10, r = c & 1023, row = r >> 4, ch = r & 15; *(u32x4*)(QL + (dir * 64 + row) * 272 + ch * 16) = cr[6 + i]; }
    if (nu >= 0) hgc_load(f, nu, cr);
    LDS_BARRIER();
    f32x4 acc[4];
#pragma unroll
    for (int mb = 0; mb < 4; ++mb) acc[mb] = (f32x4){0.f, 0.f, 0.f, 0.f};
#pragma unroll
    for (int dir = 0; dir < 2; ++dir) {
        const char* qs = QL + (dir * 64 + lr) * 272;
#pragma unroll
        for (int mb = 0; mb < 4; ++mb)
#pragma unroll
            for (int ks = 0; ks < 4; ++ks) { const bf16x8 qf = *(const bf16x8*)(qs + mb * 16 * 272 + (ks * 32 + lg * 8) * 2); acc[mb] = __builtin_amdgcn_mfma_f32_16x16x32_bf16(qf, sf[dir][ks], acc[mb], 0, 0, 0); }
    }
    LDS_BARRIER();
#pragma unroll
    for (int mb = 0; mb < 4; ++mb)
#pragma unroll
        for (int i = 0; i < 4; ++i) { acc[mb][i] += OS[(mb * 16 + lg * 4 + i) * 132 + wid * 16 + lr];
            float v = acc[mb][i] * acc[mb][i]; v += __shfl_xor(v, 1); v += __shfl_xor(v, 2); v += __shfl_xor(v, 4); v += __shfl_xor(v, 8);
            if (lr == 0) red[wid * 64 + mb * 16 + lg * 4 + i] = v; }
    LDS_BARRIER();
    const float gn = f.in[I_HGN][l * 512 + ecol];
#pragma unroll
    for (int mb = 0; mb < 4; ++mb)
#pragma unroll
        for (int i = 0; i < 4; ++i) { const int tl = mb * 16 + lg * 4 + i, tok = tile * 64 + tl; float ss = 0.f;
#pragma unroll
            for (int w = 0; w < 8; ++w) ss += red[w * 64 + tl];
            const float gz = bf2f(GZ[tl * 128 + wid * 16 + lr]);
            omix[(size_t)tok * DM + ecol] = f2bf(acc[mb][i] * rsqrtf(ss * (1.0f / 128.0f) + 1e-6f) * gn * (gz * __builtin_amdgcn_rcpf(1.0f + __expf(-gz)))); }
}
}
__device__ __forceinline__ void ph_hg_passA(const F& fin, int l) {
    const F f = launder(fin);
    hg::u32x4 zr[6];
    { int v = xcd_deal(f, 0, 2 * 4 * 192); if (v >= 0) hg::hg_zload(f, (v >> 3) + 192 * (v & 7), zr);
      for (int k = 0; v >= 0; ++k) { const int vn = xcd_deal(f, k + 1, 2 * 4 * 192); const int tile = v >> 3, dh = v & 7; hg::passA(f, l, dh >> 2, dh & 3, tile, zr, vn >= 0 ? (vn >> 3) + 192 * (vn & 7) : -1); v = vn; } }
    __syncthreads();
}
__device__ __forceinline__ void ph_scan(const F& fin, int l) {
    const F f = launder(fin);
    constexpr int NB_HG = 18 * 4 * 2 * 4, NB_RG = 36, NB_PRE = NB_HG + NB_RG;
    for (int u = f.bid; u < NB_PRE; u += f.nb) {
        if (u < NB_HG) { const int qd = u & 3, dir = (u >> 2) & 1, h = (u >> 3) & 3, s = 17 - (u >> 5); hg::passB(f, l, s, h, dir, qd); }
        else { const int idx = (u - NB_HG) * NTHR + f.tid; if (idx < NSEQ * 1024) rg_passB(f, l, idx); }
    }
    const bool conv_first = (f.bid & 1) != 0;
    if (conv_first) ph_wconvert(f, l + 1, WC_IN + WC_OUT, l == 0 ? 7120 : 6144, f.bid, f.nb);
    for (int c = (f.bid + f.nb - NB_PRE % f.nb) % f.nb; c < 256 + 128; c += f.nb) {
        if (c < 256) { const int u = (c & 7) * 32 + (c >> 3); attn_unit<0>(f, 16 + (u >> 7), (u >> 4) & 7, u & 15); }
        else { const int v = c - 256; attn_unit<0>(f, v >> 3, v & 7, 0); }
    }
#ifdef PROBE_ATT
    for (int c = (f.bid + f.nb - NB_PRE % f.nb) % f.nb; c < 256 + 128; c += f.nb) {
        if (c < 256) { const int u = (c & 7) * 32 + (c >> 3); attn_unit<PROBE_ATT>(f, 16 + (u >> 7), (u >> 4) & 7, u & 15); }
        else { const int v = c - 256; attn_unit<PROBE_ATT>(f, v >> 3, v & 7, 0); }
    }
#endif
    __syncthreads();
    if (!conv_first) ph_wconvert(f, l + 1, WC_IN + WC_OUT, l == 0 ? 7120 : 6144, f.bid, f.nb);
}
__device__ __forceinline__ void ph_mixfin2(const F& fin, int l) {
    const F f = launder(fin);
    { hg::u32x4 cr[10]; int u = xcd_deal(f, 0, 192 * 4); if (u >= 0) hg::hgc_load(f, u, cr);
      for (int k = 0; u >= 0; ++k) { const int un = xcd_deal(f, k + 1, 192 * 4); hg::passC(f, l, u >> 2, u & 3, cr, un); u = un; }
      __syncthreads(); }
    rg_passC(f);
}
__device__ __forceinline__ void ph_ln1(const F& fin, int l) {
    const F f = launder(fin);
    bf16_t* x1 = (bf16_t*)(f.ws + WS_X1); bf16_t* hf = (bf16_t*)(f.ws + WS_HF); float* probsT = (float*)(f.ws + WS_PROB);
    const float* g = f.in[I_LN1G] + l * DM; const float* b = f.in[I_LN1B] + l * DM;
    const int wave = f.tid >> 6, lane = f.tid & 63, r = lane & 15, kq = lane >> 4, cb = wave * 256 + kq * 8;
    float* SP = (float*)f.lds;
    float* LP = SP + 2 * 8 * 16 * 2;
    bf16x8_t bh[8], bl[8];
    { const float* rt = (const float*)(f.ws + WS_RT) + ((size_t)l * 16 + r) * DM + cb;
#pragma unroll
      for (int s = 0; s < 8; ++s) { const f32x4_t w0 = *(const f32x4_t*)(rt + 32 * s), w1 = *(const f32x4_t*)(rt + 32 * s + 4); const float w[8] = {w0[0], w0[1], w0[2], w0[3], w1[0], w1[1], w1[2], w1[3]};
          u32x4_t hi, lo;
#pragma unroll
          for (int j = 0; j < 4; ++j) { const unsigned hp = cvtpk2(w[2 * j], w[2 * j + 1]); hi[j] = hp; lo[j] = cvtpk2(w[2 * j] - __uint_as_float(hp << 16), w[2 * j + 1] - __uint_as_float(hp & 0xffff0000u)); }
          bh[s] = __builtin_bit_cast(bf16x8_t, hi); bl[s] = __builtin_bit_cast(bf16x8_t, lo); } }
    __syncthreads();
    const int par = 0;
    u32x4_t xw[8];
    { const unsigned ro = ((unsigned)((f.bid * 16 < NT ? f.bid * 16 : 0) + r) * DM + cb) * 2u;
#pragma unroll
      for (int s = 0; s < 8; ++s) xw[s] = *(const u32x4_t*)((const unsigned char*)x1 + ro + 64 * s); }
    for (int T0 = f.bid * 16; T0 < NT; T0 += f.nb * 16) {
        const unsigned ro = ((unsigned)(T0 + r) * DM + cb) * 2u;
        const float* m = f.modp(l, tok_group(T0));
        u32x4_t xn[8];
        { const int Tn = T0 + f.nb * 16 < NT ? T0 + f.nb * 16 : T0; const unsigned rn = ((unsigned)(Tn + r) * DM + cb) * 2u;
#pragma unroll
          for (int s = 0; s < 8; ++s) xn[s] = *(const u32x4_t*)((const unsigned char*)x1 + rn + 64 * s); }
        float s1 = 0.f, s2 = 0.f;
#pragma unroll
        for (int s = 0; s < 8; ++s)
#pragma unroll
            for (int j = 0; j < 4; ++j) { const float a = __uint_as_float(xw[s][j] << 16), c = __uint_as_float(xw[s][j] & 0xffff0000u); s1 += a + c; s2 += a * a + c * c; }
        s1 += __shfl_xor(s1, 16); s2 += __shfl_xor(s2, 16); s1 += __shfl_xor(s1, 32); s2 += __shfl_xor(s2, 32);
        if (kq == 0) { float* p = SP + ((par * 8 + wave) * 16 + r) * 2; p[0] = s1; p[1] = s2; }
        LDS_BARRIER();
#pragma unroll
        for (int s = 0; s < 8; ++s) asm volatile("" : "+v"(xw[s]));
        float t1 = 0.f, t2 = 0.f;
#pragma unroll
        for (int w = 0; w < 8; ++w) { const float* p = SP + ((par * 8 + w) * 16 + r) * 2; t1 += p[0]; t2 += p[1]; }
        const float mu = t1 * (1.0f / DM), rstd = rsqrtf(fmaxf(t2 * (1.0f / DM) - mu * mu, 0.f) + 1e-5f);
        if (wave == 0 && kq == 0) { float* st = (float*)(f.ws + WS_LNS) + 2 * (T0 + r); st[0] = mu; st[1] = rstd; }
        f32x4_t acc = {0.f, 0.f, 0.f, 0.f};
#pragma unroll
        for (int s = 0; s < 8; ++s) {
            const int c = cb + 32 * s;
            const f32x4_t g0 = *(const f32x4_t*)(g + c), g1 = *(const f32x4_t*)(g + c + 4), b0 = *(const f32x4_t*)(b + c), b1 = *(const f32x4_t*)(b + c + 4);
            const f32x4_t c0 = *(const f32x4_t*)(m + 4 * DM + c), c1 = *(const f32x4_t*)(m + 4 * DM + c + 4), h0 = *(const f32x4_t*)(m + 3 * DM + c), h1 = *(const f32x4_t*)(m + 3 * DM + c + 4);
            const float gv[8] = {g0[0], g0[1], g0[2], g0[3], g1[0], g1[1], g1[2], g1[3]}, bv[8] = {b0[0], b0[1], b0[2], b0[3], b1[0], b1[1], b1[2], b1[3]};
            const float cv[8] = {c0[0], c0[1], c0[2], c0[3], c1[0], c1[1], c1[2], c1[3]}, hv[8] = {h0[0], h0[1], h0[2], h0[3], h1[0], h1[1], h1[2], h1[3]};
            u32x4_t ho, lo;
#pragma unroll
            for (int j = 0; j < 4; ++j) {
                const float xa = __uint_as_float(xw[s][j] << 16), xb = __uint_as_float(xw[s][j] & 0xffff0000u);
                const float ya = (xa - mu) * rstd * gv[2 * j] + bv[2 * j], yb = (xb - mu) * rstd * gv[2 * j + 1] + bv[2 * j + 1];
                const float ha = ya * (cv[2 * j] + 1.0f) + hv[2 * j], hb = yb * (cv[2 * j + 1] + 1.0f) + hv[2 * j + 1];
                const unsigned hp = cvtpk2(ha, hb); ho[j] = hp; lo[j] = cvtpk2(ha - __uint_as_float(hp << 16), hb - __uint_as_float(hp & 0xffff0000u));
            }
            *(u32x4_t*)((unsigned char*)hf + ro + 64 * s) = ho;
            const bf16x8_t ah = __builtin_bit_cast(bf16x8_t, ho), al = __builtin_bit_cast(bf16x8_t, lo);
            acc = __builtin_amdgcn_mfma_f32_16x16x32_bf16(ah, bh[s], acc, 0, 0, 0);
            acc = __builtin_amdgcn_mfma_f32_16x16x32_bf16(ah, bl[s], acc, 0, 0, 0);
            acc = __builtin_amdgcn_mfma_f32_16x16x32_bf16(al, bh[s], acc, 0, 0, 0);
        }
#pragma unroll
        for (int j = 0; j < 4; ++j) LP[((par * 8 + wave) * 16 + kq * 4 + j) * 16 + r] = acc[j];
        LDS_BARRIER();
        if (f.tid < 256) {
            const int tok = f.tid >> 4, e = f.tid & 15; float v = 0.f;
#pragma unroll
            for (int w = 0; w < 8; ++w) v += LP[((par * 8 + w) * 16 + tok) * 16 + e];
            float mx = v; mx = fmaxf(mx, __shfl_xor(mx, 1)); mx = fmaxf(mx, __shfl_xor(mx, 2)); mx = fmaxf(mx, __shfl_xor(mx, 4)); mx = fmaxf(mx, __shfl_xor(mx, 8));
            const float ex = expf(v - mx); float sm = ex; sm += __shfl_xor(sm, 1); sm += __shfl_xor(sm, 2); sm += __shfl_xor(sm, 4); sm += __shfl_xor(sm, 8);
            probsT[(size_t)e * NT + T0 + tok] = ex / sm;
        }
#pragma unroll
        for (int s = 0; s < 8; ++s) xw[s] = xn[s];
    }
}
template <int KPT>
__device__ __forceinline__ void select_unit(const F& f, int set, int e) {
    const float* probsT = (const float*)(f.ws + WS_PROB); int* slot = (int*)(f.ws + WS_SLOT); int* ridx = (int*)(f.ws + WS_RIDX); float* gate = (float*)(f.ws + WS_GATE);
    unsigned* hist = (unsigned*)f.lds;
    unsigned* ctl = hist + 256;
    unsigned* wsum = ctl + 8;
    const int tid = f.tid, wave = tid >> 6, lane = tid & 63;
    const int j0 = set ? NCTX : 0, cap = set ? CAPL : CAPC;
    unsigned key[KPT];
    { const float* src = probsT + (size_t)e * NT + j0 + tid * KPT;
#pragma unroll
      for (int j = 0; j < KPT; j += 4) { const f32x4_t p = *(const f32x4_t*)(src + j); key[j] = __float_as_uint(p[0]); key[j + 1] = __float_as_uint(p[1]); key[j + 2] = __float_as_uint(p[2]); key[j + 3] = __float_as_uint(p[3]); } }
    unsigned prefix = 0u, mask = 0u, remaining = (unsigned)cap;
#pragma unroll 1
    for (int pass = 3; pass >= 0; --pass) {
        __syncthreads();
        if (tid < 256) hist[tid] = 0u;
        __syncthreads();
#pragma unroll
        for (int j = 0; j < KPT; ++j) if ((key[j] & mask) == prefix) atomicAdd(&hist[(key[j] >> (8 * pass)) & 255u], 1u);
        __syncthreads();
        if (wave == 0) {
            const unsigned h0 = hist[4 * lane], h1 = hist[4 * lane + 1], h2 = hist[4 * lane + 2], h3 = hist[4 * lane + 3];
            const unsigned tot = h0 + h1 + h2 + h3; unsigned suf = tot;
            for (int o = 1; o < 64; o <<= 1) { const unsigned v = __shfl_down(suf, o); if (lane + o < 64) suf += v; }
            const unsigned above = suf - tot;
            const unsigned s3 = above + h3, s2 = s3 + h2, s1 = s2 + h1, s0 = s1 + h0;
            if (s3 >= remaining && above < remaining) { ctl[0] = 4 * lane + 3; ctl[1] = remaining - above; }
            else if (s2 >= remaining && s3 < remaining) { ctl[0] = 4 * lane + 2; ctl[1] = remaining - s3; }
            else if (s1 >= remaining && s2 < remaining) { ctl[0] = 4 * lane + 1; ctl[1] = remaining - s2; }
            else if (s0 >= remaining && s1 < remaining) { ctl[0] = 4 * lane; ctl[1] = remaining - s1; }
        }
        __syncthreads();
        prefix |= ctl[0] << (8 * pass); mask |= 255u << (8 * pass); remaining = ctl[1];
    }
    const unsigned T = prefix, take_eq = remaining, cnt_gt = (unsigned)cap - take_eq;
    unsigned cg = 0u, ce = 0u;
#pragma unroll
    for (int j = 0; j < KPT; ++j) { cg += key[j] > T ? 1u : 0u; ce += key[j] == T ? 1u : 0u; }
    unsigned packed = (cg << 16) | ce, inc = packed;
    for (int o = 1; o < 64; o <<= 1) { const unsigned v = __shfl_up(inc, o); if (lane >= o) inc += v; }
    __syncthreads();
    if (lane == 63) wsum[wave] = inc;
    __syncthreads();
    unsigned base = 0u;
    for (int w = 0; w < wave; ++w) base += wsum[w];
    unsigned excl = base + inc - packed; unsigned pg = excl >> 16, pe = excl & 0xffffu;
    const int row0 = e * EROWS + (set ? CAPC : 0);
#pragma unroll
    for (int j = 0; j < KPT; ++j) {
        const int t = j0 + tid * KPT + j; int row = -1;
        if (key[j] > T) { row = row0 + (int)pg; ++pg; }
        else if (key[j] == T) { if (pe < take_eq) row = row0 + (int)(cnt_gt + pe); ++pe; }
        slot[(size_t)t * 16 + e] = row;
        if (row >= 0) { ridx[row] = t; gate[row] = __uint_as_float(key[j]); }
    }
}
__device__ __forceinline__ void ph_select(const F& fin) {
    const F f = launder(fin);
    for (int u = f.bid; u < 32; u += f.nb) { if (u < 16) select_unit<16>(f, 1, u); else select_unit<8>(f, 0, u - 16); }
    __syncthreads();
}
__device__ __forceinline__ void ln2_fill(const F& f, int l) {
    float* PL = (float*)f.lds;
    { const int ln_ = l + 1 < DEPTH ? l + 1 : l; __syncthreads();
      for (int i = f.tid; i < 13 * DM / 4; i += NTHR) { const int v = i / (DM / 4), c = (i % (DM / 4)) * 4; const float* src;
          if (v < 3) src = f.modp(l, v) + 5 * DM; else if (v == 3) src = f.in[I_LN2G] + l * DM; else if (v == 4) src = f.in[I_LN2B] + l * DM; else if (v < 8) src = f.modp(ln_, v - 5) + DM; else if (v < 11) src = f.modp(ln_, v - 8); else if (v == 11) src = f.in[I_LN1G] + l * DM; else src = f.in[I_LN1B] + l * DM;
          *(f32x4_t*)(PL + v * DM + c) = *(const f32x4_t*)(src + c); }
      __syncthreads(); }
}
__device__ __forceinline__ void ph_ln2(const F& fin, int l) {
    const F f = launder(fin);
    const bf16_t* x1 = (const bf16_t*)(f.ws + WS_X1); const bf16_t* ys = (const bf16_t*)(f.ws + WS_XS); const int* slot = (const int*)(f.ws + WS_SLOT);
    float* xo = f.out + O_Y; bf16_t* xnb = (bf16_t*)(f.ws + WS_XN); bf16_t* hm = (bf16_t*)(f.ws + WS_HM);
    const int wave = f.tid >> 6, lane = f.tid & 63;
    float* PL = (float*)f.lds;
    const float* g = PL + 3 * DM; const float* b = PL + 4 * DM;
    const int tfirst = f.bid * 8 + wave, tstr = f.nb * 8;
    typedef float f32x2_t __attribute__((ext_vector_type(2))); const f32x2_t* lns = (const f32x2_t*)(f.ws + WS_LNS); const float* g1v = PL + 11 * DM; const float* b1v = PL + 12 * DM;
    int sl = -1; u32x4_t xr[4]; f32x2_t st;
    { const int tc = tfirst < NT ? tfirst : 0; sl = lane < 16 ? slot[(size_t)tc * 16 + lane] : -1; st = lns[tc];
#pragma unroll
      for (int i = 0; i < 4; ++i) xr[i] = *(const u32x4_t*)(x1 + (size_t)tc * DM + i * 512 + lane * 8); }
    for (int t = tfirst; t < NT; t += tstr) {
        const int grp = tok_group(t); const float* m = PL + grp * DM - 5 * DM;
        const int tnx = t + tstr < NT ? t + tstr : t;
        const int sln = lane < 16 ? slot[(size_t)tnx * 16 + lane] : -1; const f32x2_t stn = lns[tnx];
        u32x4_t xrn[4];
#pragma unroll
        for (int i = 0; i < 4; ++i) xrn[i] = *(const u32x4_t*)(x1 + (size_t)tnx * DM + i * 512 + lane * 8);
        float acc[4][8];
#pragma unroll
        for (int i = 0; i < 4; ++i)
#pragma unroll
            for (int j = 0; j < 8; ++j) acc[i][j] = 0.f;
        unsigned long long msk = __ballot(sl >= 0);
        while (msk) {
            const int e0 = __builtin_ctzll(msk); msk &= msk - 1; const int r0 = __shfl(sl, e0);
            int r1 = -1; if (msk) { const int e1 = __builtin_ctzll(msk); msk &= msk - 1; r1 = __shfl(sl, e1); }
            u32x4_t ra[4], rb[4];
#pragma unroll
            for (int i = 0; i < 4; ++i) { ra[i] = *(const u32x4_t*)(ys + (size_t)r0 * DM + i * 512 + lane * 8); rb[i] = r1 >= 0 ? *(const u32x4_t*)(ys + (size_t)r1 * DM + i * 512 + lane * 8) : (u32x4_t){0u, 0u, 0u, 0u}; }
#pragma unroll
            for (int i = 0; i < 4; ++i) { const unsigned wa[4] = {ra[i].x, ra[i].y, ra[i].z, ra[i].w}, wb[4] = {rb[i].x, rb[i].y, rb[i].z, rb[i].w};
#pragma unroll
                for (int j = 0; j < 4; ++j) { acc[i][2 * j] += __uint_as_float(wa[j] << 16) + __uint_as_float(wb[j] << 16); acc[i][2 * j + 1] += __uint_as_float(wa[j] & 0xffff0000u) + __uint_as_float(wb[j] & 0xffff0000u); } }
        }
        float v[4][8]; float s1 = 0.f;
#pragma unroll
        for (int i = 0; i < 4; ++i) { const int c = i * 512 + lane * 8; const f32x4_t ga = *(const f32x4_t*)(m + 5 * DM + c), gb = *(const f32x4_t*)(m + 5 * DM + c + 4);
            const unsigned xw[4] = {xr[i].x, xr[i].y, xr[i].z, xr[i].w}; float xf[8];
#pragma unroll
            for (int j = 0; j < 4; ++j) { xf[2 * j] = __uint_as_float(xw[j] << 16); xf[2 * j + 1] = __uint_as_float(xw[j] & 0xffff0000u); }
            { const f32x4_t ga1 = *(const f32x4_t*)(g1v + c), gb1 = *(const f32x4_t*)(g1v + c + 4), ba1 = *(const f32x4_t*)(b1v + c), bb1 = *(const f32x4_t*)(b1v + c + 4);
#pragma unroll
              for (int j = 0; j < 4; ++j) { xf[j] = (xf[j] - st[0]) * st[1] * ga1[j] + ba1[j]; xf[4 + j] = (xf[4 + j] - st[0]) * st[1] * gb1[j] + bb1[j]; } }
#pragma unroll
            for (int j = 0; j < 4; ++j) { v[i][j] = ALPHA * xf[j] + ga[j] * acc[i][j]; v[i][4 + j] = ALPHA * xf[4 + j] + gb[j] * acc[i][4 + j]; s1 += v[i][j] + v[i][4 + j]; } }
        for (int o = 32; o >= 1; o >>= 1) s1 += __shfl_xor(s1, o);
        const float mu = s1 * (1.0f / DM); float qq = 0.f;
#pragma unroll
        for (int i = 0; i < 4; ++i)
#pragma unroll
            for (int j = 0; j < 8; ++j) { v[i][j] -= mu; qq += v[i][j] * v[i][j]; }
        for (int o = 32; o >= 1; o >>= 1) qq += __shfl_xor(qq, o);
        const float rstd = rsqrtf(qq * (1.0f / DM) + 1e-5f);
        const float* mn = PL + (8 + grp) * DM;
        const float* mnsc = PL + (5 + grp) * DM;
#pragma unroll
        for (int i = 0; i < 4; ++i) { const int c = i * 512 + lane * 8; const f32x4_t ga = *(const f32x4_t*)(g + c), gb = *(const f32x4_t*)(g + c + 4), ba = *(const f32x4_t*)(b + c), bb = *(const f32x4_t*)(b + c + 4);
            f32x4_t ya, yb;
#pragma unroll
            for (int j = 0; j < 4; ++j) { ya[j] = v[i][j] * rstd * ga[j] + ba[j]; yb[j] = v[i][4 + j] * rstd * gb[j] + bb[j]; }
            if (l + 1 >= DEPTH) { *(f32x4_t*)(xo + (size_t)t * DM + c) = ya; *(f32x4_t*)(xo + (size_t)t * DM + c + 4) = yb; }
            else { const u32x4_t wx = {cvtpk2(ya[0], ya[1]), cvtpk2(ya[2], ya[3]), cvtpk2(yb[0], yb[1]), cvtpk2(yb[2], yb[3])}; *(u32x4_t*)(xnb + (size_t)t * DM + c) = wx; }
            if (l + 1 < DEPTH) { const f32x4_t sa = *(const f32x4_t*)(mnsc + c), sb = *(const f32x4_t*)(mnsc + c + 4), ha = *(const f32x4_t*)(mn + c), hb = *(const f32x4_t*)(mn + c + 4);
                const f32x4_t ma = ya * (sa + 1.0f) + ha, mb = yb * (sb + 1.0f) + hb;
                u32x4_t w = {cvtpk2(ma[0], ma[1]), cvtpk2(ma[2], ma[3]), cvtpk2(mb[0], mb[1]), cvtpk2(mb[2], mb[3])};
                *(u32x4_t*)(hm + (size_t)t * DM + c) = w; } }
        sl = sln; st = stn;
#pragma unroll
        for (int i = 0; i < 4; ++i) xr[i] = xrn[i];
    }
}

#define PG8_LDS(f) ((PG8_LAS unsigned char*)(f).lds)
__device__ __forceinline__ void ph_inproj(const F& fin, int l) {
    const F f = launder(fin);
    pg8::Gemm g{(const bf16_t*)(f.ws + WS_HM), (const bf16_t*)(f.ws + WS_WIN) + (size_t)l * LDZ * DM, NT, LDZ, DM, 1 << 20, 0};
    pg8::StaticOrder S; S.init(NT, LDZ, f.nb, f.bid);
    pg8::EpiB16 E{(bf16_t*)(f.ws + WS_Z), LDZ, 0, 0};
    pg8::gemm_phase<pg8::EpiB16, pg8::StaticOrder, false>(PG8_LDS(f), g, S, E, nullptr);
    if (f.bid >= 144) ph_wconvert(f, l + 1, 0, WC_IN, f.bid - 144, 112);
}
__device__ __forceinline__ void ph_up(const F& fin, int l) {
    const F f = launder(fin);
    { pg8::Gemm g{(const bf16_t*)(f.ws + WS_CKVA), (const bf16_t*)(f.ws + WS_WUKV) + (size_t)l * 2048 * 512, NKV, 2048, 512, 1 << 20, 0};
      pg8::StaticOrder S; S.init(NKV, 2048, f.nb, f.bid);
      pg8::EpiB16 E{(bf16_t*)(f.ws + WS_KN), 1024, 1024, (size_t)(WS_VV - WS_KN) / 2};
      pg8::gemm_phase<pg8::EpiB16, pg8::StaticOrder, false>(PG8_LDS(f), g, S, E, nullptr); }
    { pg8::Gemm g{(const bf16_t*)(f.ws + WS_CQN), (const bf16_t*)(f.ws + WS_WUQ) + (size_t)l * 1536 * 512, NT, 1536, 512, 1 << 20, 0};
      pg8::StaticOrder S; S.init(NT, 1536, f.nb, (f.bid + 96) % f.nb);
      pg8::EpiB16 E{(bf16_t*)(f.ws + WS_QM), 1536, 0, 0};
      pg8::gemm_phase<pg8::EpiB16, pg8::StaticOrder, false>(PG8_LDS(f), g, S, E, nullptr); }
}
__device__ __forceinline__ void ph_outproj(const F& fin, int l) {
    const F f = launder(fin);
    pg8::Gemm g{(const bf16_t*)(f.ws + WS_OMIX), (const bf16_t*)(f.ws + WS_WOUT) + (size_t)l * DM * DM, NT, DM, DM, 1 << 20, 0};
    pg8::StaticOrder S; S.init(NT, DM, f.nb, f.bid);
    const float* xbase = l == 0 ? f.in[I_XP] : (const float*)(f.ws + WS_XN);
    const long long dlat = l == 0 ? (long long)(f.in[I_XS] - f.in[I_XP]) - (long long)NCTX * DM : 0ll;
    pg8::EpiOutProj E{xbase, dlat, (const float*)(f.ws + WS_MODS) + (size_t)l * 3 * 6 * DM, (bf16_t*)(f.ws + WS_X1), l == 0 ? (const bf16_t*)nullptr : (const bf16_t*)(f.ws + WS_XN)};
    pg8::gemm_phase<pg8::EpiOutProj, pg8::StaticOrder, false>(PG8_LDS(f), g, S, E, nullptr);
    if (f.bid >= 128) ph_wconvert(f, l + 1, WC_IN, WC_IN + WC_OUT, f.bid - 128, 128);
}
__device__ __forceinline__ void ph_moe1(const F& fin, int l) {
    const F f = launder(fin);
    pg8::Gemm g{(const bf16_t*)(f.ws + WS_HF), (const bf16_t*)(f.ws + WS_WGU) + (size_t)l * NEXP * 2048 * DM, NSLOT, 2048, DM, EROWS / 256, (size_t)2048 * DM};
    pg8::StaticOrder S; S.init(NSLOT, 2048, f.nb, f.bid);
    pg8::EpiMoe1 E{(bf16_t*)(f.ws + WS_HID)};
    pg8::gemm_phase<pg8::EpiMoe1, pg8::StaticOrder, false, true>(PG8_LDS(f), g, S, E, nullptr, (const int*)(f.ws + WS_RIDX));
}
__device__ __forceinline__ void ph_moe2(const F& fin, int l) {
    const F f = launder(fin);
    pg8::Gemm g{(const bf16_t*)(f.ws + WS_HID), (const bf16_t*)(f.ws + WS_WD) + (size_t)l * NEXP * DM * DFF, NSLOT, DM, DFF, EROWS / 256, (size_t)DM * DFF};
    pg8::StaticOrder S; S.init(NSLOT, DM, f.nb, f.bid);
    pg8::EpiMoe2 E{(bf16_t*)(f.ws + WS_XS), (const float*)(f.ws + WS_GATE)};
    pg8::gemm_phase<pg8::EpiMoe2, pg8::StaticOrder, false>(PG8_LDS(f), g, S, E, nullptr);
    ln2_fill(launder(f), l);
}

constexpr int PH_PER_LAYER = 12, NPH = 1 + DEPTH * PH_PER_LAYER;
__global__ void __launch_bounds__(NTHR, 2) mk_fwd(Args a) {
    extern __shared__ __attribute__((aligned(16))) unsigned char lds[];
    F f; f.in = a.in; f.out = a.out; f.ws = a.ws; f.lds = lds; f.tid = threadIdx.x; f.bid = blockIdx.x; f.nb = gridDim.x;
    volatile LAS unsigned* misc = (volatile LAS unsigned*)((LAS unsigned char*)lds + LDS_MISC);
    if (f.tid < 32) misc[f.tid] = 0u;
    __syncthreads();
    XcdBarrier bar = xcd_barrier_post((unsigned*)(a.ws + WS_CTL) + 4096, misc + 8);
    const int lo = a.ph_lo, hi = a.ph_hi;
#ifdef REPEAT_PH
#ifndef REPEAT_N
#define REPEAT_N 1
#endif
#define PHASE(k, call) do { if (lo <= (k) && (k) < hi) { if (((k) == 0 ? 0 : ((k) - 1) % PH_PER_LAYER + 1) == REPEAT_PH) { for (int rep_ = 0; rep_ < REPEAT_N; ++rep_) { call; xcd_barrier(bar); } } call; if ((k) + 1 < hi) xcd_barrier(bar); } } while (0)
#elif defined(ONLYPH)
#define PHASE(k, call) do { if (((k) == 0 ? 0 : ((k) - 1) % PH_PER_LAYER + 1) == ONLYPH) { if (lo <= (k) && (k) < hi) { call; if ((k) + 1 < hi) xcd_barrier(bar); } } } while (0)
#else
#define PHASE(k, call) do { if (lo <= (k) && (k) < hi) { call; if ((k) + 1 < hi) xcd_barrier(bar); } } while (0)
#endif
    PHASE(0, { ph_prologue(f); ph_rgw(launder(f)); { const F fl = launder(f); ph_wconvert(fl, 0, 0, 976, fl.bid, fl.nb); } });
    for (int l = 0; l < DEPTH; ++l) {
        const int p = 1 + l * PH_PER_LAYER;
        if (l == 0) PHASE(p + 0, ph_mod(f, l));
        PHASE(p + 1, ph_inproj(f, l));
        PHASE(p + 2, ph_prep(f, l));
        PHASE(p + 3, { ph_up(f, l); ph_rg_units(f, l); ph_hg_passA(f, l); });
        PHASE(p + 4, ph_scan(f, l));
        PHASE(p + 5, ph_mixfin2(f, l));
        PHASE(p + 6, ph_outproj(f, l));
        PHASE(p + 7, ph_ln1(f, l));
        PHASE(p + 8, ph_select(f));
        PHASE(p + 9, ph_moe1(f, l));
        PHASE(p + 10, ph_moe2(f, l));
        PHASE(p + 11, ph_ln2(f, l));
    }
#undef PHASE
}

extern "C" void kernel_launch(void* const* d_in, const int* in_sizes, int n_in, void* d_out, int out_size, void* d_ws, size_t ws_size, hipStream_t stream) {
    static int grid = 0;
    if (grid == 0) {
        if (n_in != N_IN || (size_t)out_size != O_END || ws_size < WS_END) { fprintf(stderr, "kernel_launch: shape mismatch n_in %d out %d ws %zu (need %zu)\n", n_in, out_size, ws_size, (size_t)WS_END); grid = -1; return; }
        int dev = 0, cus = 0, per_cu = 0;
        if (hipGetDevice(&dev) != hipSuccess || hipDeviceGetAttribute(&cus, hipDeviceAttributeMultiprocessorCount, dev) != hipSuccess) { grid = -1; return; }
        if (hipFuncSetAttribute((const void*)mk_fwd, hipFuncAttributeMaxDynamicSharedMemorySize, LDS_BYTES) != hipSuccess) { fprintf(stderr, "kernel_launch: hipFuncSetAttribute failed\n"); grid = -1; return; }
        if (hipOccupancyMaxActiveBlocksPerMultiprocessor(&per_cu, (const void*)mk_fwd, NTHR, LDS_BYTES) != hipSuccess || per_cu < 1) { fprintf(stderr, "kernel_launch: occupancy query says %d\n", per_cu); }
        (void)hipGetLastError();
        grid = cus;
    }
    if (grid < 0) return;
    if (hipMemsetAsync((char*)d_ws + WS_CTL, 0, CTL_ZERO, stream) != hipSuccess) return;
    Args a{};
    for (int i = 0; i < N_IN; ++i) a.in[i] = (const float*)d_in[i];
    a.out = (float*)d_out; a.ws = (unsigned char*)d_ws; a.ph_lo = 0; a.ph_hi = NPH;
    hipLaunchKernelGGL(mk_fwd, dim3(grid), dim3(NTHR), LDS_BYTES, stream, a);
}
```
